# Optimizing an MI355X kernel written in HIP

```python
import jax, jax.numpy as jnp
from jax import lax
import numpy as np

D_MODEL = 1024
BATCH = 8
SEQ = 4096
DEPTH = 1
DEC_BATCH = 128
DEC_SEQ = 1
PAST_LEN = 16384
PAGE_SIZE = 128

M_HEADS = 4
M_V_DIM = D_MODEL // M_HEADS
M_QK_DIM = M_V_DIM // 2
M_CHUNK = 64
CONV_W = 4
QK_CH = 2 * M_HEADS * M_QK_DIM
A_HEADS = 16
A_KV_HEADS = 2
A_HEAD_DIM = D_MODEL // A_HEADS
A_GROUP = A_HEADS // A_KV_HEADS
WINDOW = 128
D_FF = ((8 * D_MODEL // 3 + 255) // 256) * 256
P_DIM = 256
LN_EPS = 1e-5
RMS_EPS = 1e-6
ALPHA = (2 * DEPTH) ** 0.25
BETA = (8 * DEPTH) ** -0.25
SPLIT_SIZES = (QK_CH, M_HEADS * M_V_DIM, M_HEADS, M_HEADS, M_HEADS * M_V_DIM,
               A_HEADS * A_HEAD_DIM, A_KV_HEADS * A_HEAD_DIM, A_KV_HEADS * A_HEAD_DIM,
               D_MODEL, D_MODEL)
IN_WIDTH = sum(SPLIT_SIZES)

kernel_name = 'hybrid_mlstm_swa_sink_deepnorm_step'


def layer_norm(x, g, b):
    xf = x.astype(jnp.float32)
    mu = jnp.mean(xf, -1, keepdims=True)
    var = jnp.mean(jnp.square(xf - mu), -1, keepdims=True)
    return ((xf - mu) * lax.rsqrt(var + LN_EPS) * g + b).astype(x.dtype)


def split_points():
    return [int(s) for s in np.cumsum(SPLIT_SIZES)[:-1]]


def causal_dwconv(x, buf, w, b):
    ext = jnp.concatenate([buf.astype(x.dtype), x], axis=1)
    y = lax.conv_general_dilated(ext, w[:, None, :].astype(x.dtype), window_strides=(1,),
                                 padding='VALID', dimension_numbers=('NWC', 'WIO', 'NWC'),
                                 feature_group_count=x.shape[-1])
    return jax.nn.silu(y + b), ext[:, -(CONV_W - 1):]


def mlstm_chunkwise(q, k, v, i_pre, f_pre, C0, n0, m0):
    B, S, H, DK = q.shape
    L = M_CHUNK if S % M_CHUNK == 0 else S
    nc = S // L
    f32 = jnp.float32

    def to_chunks(a):
        a = a.astype(f32).reshape((B, nc, L) + a.shape[2:])
        return jnp.moveaxis(a, 1, 0)

    xs = (to_chunks(q), to_chunks(k) * (DK ** -0.5), to_chunks(v), to_chunks(i_pre), to_chunks(f_pre))
    causal = jnp.tril(jnp.ones((L, L), dtype=bool))

    def step(carry, inp):
        C, n, m = carry
        qc, kc, vc, ic, fc = inp
        bcum = jnp.swapaxes(jnp.cumsum(jax.nn.log_sigmoid(fc), axis=1), 1, 2)
        logi = jnp.swapaxes(ic, 1, 2)
        dmat = bcum[..., :, None] - bcum[..., None, :] + logi[..., None, :]
        dmat = jnp.where(causal, dmat, -jnp.inf)
        m_inter = bcum + m[..., None]
        m_t = jnp.maximum(m_inter, jnp.max(dmat, -1))
        w = jnp.exp(dmat - m_t[..., None]) * jnp.einsum('bthd,bshd->bhts', qc, kc)
        inter = jnp.exp(m_inter - m_t)
        num = (jnp.einsum('bhts,bshv->bthv', w, vc)
               + jnp.swapaxes(inter, 1, 2)[..., None] * jnp.einsum('bthd,bhdv->bthv', qc, C))
        den = jnp.sum(w, -1) + inter * jnp.einsum('bthd,bhd->bht', qc, n)
        denom = jnp.maximum(jnp.abs(den), jnp.exp(-m_t))
        h = num / jnp.swapaxes(denom, 1, 2)[..., None]
        m_new = m_t[..., -1]
        decay_prev = jnp.exp(bcum[..., -1] + m - m_new)
        w_state = jnp.exp(bcum[..., -1:] - bcum + logi - m_new[..., None])
        C_new = decay_prev[..., None, None] * C + jnp.einsum('bhs,bshd,bshv->bhdv', w_state, kc, vc)
        n_new = decay_prev[..., None] * n + jnp.einsum('bhs,bshd->bhd', w_state, kc)
        return (C_new, n_new, m_new), h

    (C, n, m), hs = lax.scan(step, (C0.astype(f32), n0.astype(f32), m0.astype(f32)), xs)
    h = jnp.moveaxis(hs, 0, 1).reshape(B, S, H, hs.shape[-1])
    return h, C, n, m


def window_attention(q, k, v, k_buf, v_buf, sinks, start):
    B, S = q.shape[0], q.shape[1]
    Q = WINDOW if S % WINDOW == 0 else S
    nb = S // Q
    k_ext = jnp.concatenate([k_buf.astype(k.dtype), k], axis=1)
    v_ext = jnp.concatenate([v_buf.astype(v.dtype), v], axis=1)
    idx = (jnp.arange(nb) * Q)[:, None] + jnp.arange(WINDOW + Q)[None, :]
    kb = k_ext[:, idx]
    vb = v_ext[:, idx]
    qb = q.reshape(B, nb, Q, A_KV_HEADS, A_GROUP, A_HEAD_DIM)
    q_pos = start + jnp.arange(S).reshape(nb, Q)
    k_pos = start - WINDOW + idx
    delta = q_pos[:, :, None] - k_pos[:, None, :]
    mask = (k_pos[:, None, :] >= 0) & (delta >= 0) & (delta <= WINDOW)
    s = jnp.einsum('bnqkgd,bnskd->bnkgqs', qb, kb).astype(jnp.float32) * (A_HEAD_DIM ** -0.5)
    s = jnp.where(mask[:, None, None], s, -jnp.inf)
    sink = sinks.astype(jnp.float32).reshape(A_KV_HEADS, A_GROUP)[:, :, None, None]
    mx = jnp.maximum(jnp.max(s, -1, keepdims=True), sink)
    e = jnp.exp(s - mx)
    p = e / (jnp.sum(e, -1, keepdims=True) + jnp.exp(sink - mx))
    o = jnp.einsum('bnkgqs,bnskd->bnqkgd', p.astype(v.dtype), vb).reshape(B, S, A_HEADS * A_HEAD_DIM)
    return o, k_ext[:, -WINDOW:], v_ext[:, -WINDOW:]


def decoder_layer(x, p, conv_buf, C0, n0, m0, k_buf, v_buf, start,
                  w_in, b_igate, b_fgate, conv_w, conv_b, m_norm_g, attn_sinks, w_out,
                  ln1_g, ln1_b, w_gate_up, w_down, ln2_g, ln2_b, w_ple, w_ple_gate):
    B, S, _ = x.shape
    z = x @ w_in
    qk, mv, mi, mf, mo, aq, ak, av, gm, ga = jnp.split(z, split_points(), axis=-1)
    qk, conv_state = causal_dwconv(qk, conv_buf, conv_w, conv_b)
    mq, mk = jnp.split(qk, 2, axis=-1)
    h, C, n, m = mlstm_chunkwise(mq.reshape(B, S, M_HEADS, M_QK_DIM), mk.reshape(B, S, M_HEADS, M_QK_DIM),
                                 mv.reshape(B, S, M_HEADS, M_V_DIM), mi + b_igate, mf + b_fgate, C0, n0, m0)
    h = h * lax.rsqrt(jnp.mean(jnp.square(h), -1, keepdims=True) + RMS_EPS)
    y_m = (jax.nn.sigmoid(mo.astype(jnp.float32)) * h.reshape(B, S, D_MODEL) * m_norm_g).astype(x.dtype)
    y_a, k_win, v_win = window_attention(aq.reshape(B, S, A_HEADS, A_HEAD_DIM),
                                         ak.reshape(B, S, A_KV_HEADS, A_HEAD_DIM),
                                         av.reshape(B, S, A_KV_HEADS, A_HEAD_DIM),
                                         k_buf, v_buf, attn_sinks, start)
    mixed = jax.nn.sigmoid(gm) * y_m + jax.nn.sigmoid(ga) * y_a
    x = layer_norm(ALPHA * x + mixed @ w_out, ln1_g, ln1_b)
    g, u = jnp.split(x @ w_gate_up, 2, axis=-1)
    ffn = (jax.nn.silu(g) * u) @ w_down
    ple = jax.nn.sigmoid(x @ w_ple_gate) * (p @ w_ple)
    x = layer_norm(ALPHA * x + ffn + ple, ln2_g, ln2_b)
    return x, (C, n, m, conv_state, k_win, v_win)


def trunk(x, p, C0, n0, m0, conv0, k0, v0, start, ln_in_g, ln_in_b, layer_w):
    x = layer_norm(x, ln_in_g, ln_in_b)
    outs = []
    for l in range(DEPTH):
        x, st = decoder_layer(x, p[l], conv0[l], C0[l], n0[l], m0[l], k0[l], v0[l], start,
                              *[w[l] for w in layer_w])
        outs.append(st)
    C, n, m, conv, kw, vw = [jnp.stack(s) for s in zip(*outs)]
    return x, C, n, m, conv, kw, vw


def setup_inputs(seed: int = 0) -> dict:
    key = jax.random.key(seed)
    ks = jax.random.split(key, 32)
    nrm = jax.random.normal
    f32 = jnp.float32
    D = D_MODEL
    return {
        'x_prompt': nrm(ks[0], (BATCH, SEQ, D), f32),
        'x_sample': nrm(ks[1], (DEC_BATCH, DEC_SEQ, D), f32),
        'state_mlstm_C': 0.3 * nrm(ks[2], (DEPTH, DEC_BATCH, M_HEADS, M_QK_DIM, M_V_DIM), f32),
        'state_mlstm_n': 0.3 * nrm(ks[3], (DEPTH, DEC_BATCH, M_HEADS, M_QK_DIM), f32),
        'state_mlstm_m': nrm(ks[4], (DEPTH, DEC_BATCH, M_HEADS), f32),
        'state_conv': nrm(ks[5], (DEPTH, DEC_BATCH, CONV_W - 1, QK_CH), f32),
        'cache_win_k': nrm(ks[6], (DEPTH, DEC_BATCH, WINDOW, A_KV_HEADS, A_HEAD_DIM), f32),
        'cache_win_v': nrm(ks[7], (DEPTH, DEC_BATCH, WINDOW, A_KV_HEADS, A_HEAD_DIM), f32),
        'p_prompt': nrm(ks[8], (DEPTH, BATCH, SEQ, P_DIM), f32),
        'p_sample': nrm(ks[9], (DEPTH, DEC_BATCH, DEC_SEQ, P_DIM), f32),
        'ln_in_g': 1.0 + 0.02 * nrm(ks[10], (D,), f32),
        'ln_in_b': 0.02 * nrm(ks[11], (D,), f32),
        'w_in': nrm(ks[12], (DEPTH, D, IN_WIDTH), f32) * D ** -0.5,
        'b_igate': -1.0 + 0.5 * nrm(ks[13], (DEPTH, M_HEADS), f32),
        'b_fgate': 3.0 + 0.5 * nrm(ks[14], (DEPTH, M_HEADS), f32),
        'conv_w': nrm(ks[15], (DEPTH, CONV_W, QK_CH), f32) * CONV_W ** -0.5,
        'conv_b': 0.02 * nrm(ks[16], (DEPTH, QK_CH), f32),
        'm_norm_g': 1.0 + 0.02 * nrm(ks[17], (DEPTH, D), f32),
        'attn_sinks': 0.5 * nrm(ks[18], (DEPTH, A_HEADS), f32),
        'w_out': nrm(ks[19], (DEPTH, D, D), f32) * (D ** -0.5 * BETA),
        'ln1_g': 1.0 + 0.02 * nrm(ks[20], (DEPTH, D), f32),
        'ln1_b': 0.02 * nrm(ks[21], (DEPTH, D), f32),
        'w_gate_up': nrm(ks[22], (DEPTH, D, 2 * D_FF), f32) * D ** -0.5,
        'w_down': nrm(ks[23], (DEPTH, D_FF, D), f32) * (D_FF ** -0.5 * BETA),
        'ln2_g': 1.0 + 0.02 * nrm(ks[24], (DEPTH, D), f32),
        'ln2_b': 0.02 * nrm(ks[25], (DEPTH, D), f32),
        'w_ple': nrm(ks[26], (DEPTH, P_DIM, D), f32) * (P_DIM ** -0.5 * BETA),
        'w_ple_gate': nrm(ks[27], (DEPTH, D, D), f32) * D ** -0.5,
    }


def reference(x_prompt, x_sample, state_mlstm_C, state_mlstm_n, state_mlstm_m, state_conv,
              cache_win_k, cache_win_v, p_prompt, p_sample, ln_in_g, ln_in_b, w_in, b_igate, b_fgate,
              conv_w, conv_b, m_norm_g, attn_sinks, w_out, ln1_g, ln1_b, w_gate_up, w_down,
              ln2_g, ln2_b, w_ple, w_ple_gate):
    layer_w = (w_in, b_igate, b_fgate, conv_w, conv_b, m_norm_g, attn_sinks, w_out,
               ln1_g, ln1_b, w_gate_up, w_down, ln2_g, ln2_b, w_ple, w_ple_gate)
    B = x_prompt.shape[0]
    dt = x_prompt.dtype
    f32 = jnp.float32
    y_prompt, C_p, n_p, m_p, conv_p, k_p, v_p = trunk(
        x_prompt, p_prompt,
        jnp.zeros((DEPTH, B, M_HEADS, M_QK_DIM, M_V_DIM), f32),
        jnp.zeros((DEPTH, B, M_HEADS, M_QK_DIM), f32),
        jnp.zeros((DEPTH, B, M_HEADS), f32),
        jnp.zeros((DEPTH, B, CONV_W - 1, QK_CH), dt),
        jnp.zeros((DEPTH, B, WINDOW, A_KV_HEADS, A_HEAD_DIM), dt),
        jnp.zeros((DEPTH, B, WINDOW, A_KV_HEADS, A_HEAD_DIM), dt),
        0, ln_in_g, ln_in_b, layer_w)
    y_sample, C_s, n_s, m_s, conv_s, k_s, v_s = trunk(
        x_sample, p_sample, state_mlstm_C, state_mlstm_n, state_mlstm_m, state_conv,
        cache_win_k, cache_win_v, PAST_LEN, ln_in_g, ln_in_b, layer_w)
    return (y_prompt, y_sample, C_p, n_p, m_p, conv_p, k_p, v_p, C_s, n_s, m_s, conv_s, k_s, v_s)
```

```cpp
#include <hip/hip_runtime.h>
#include <hip/hip_cooperative_groups.h>
#include <cstdio>
#include <cstdint>
namespace cg = cooperative_groups;
namespace pg8 {
#define PG8_LAS __attribute__((address_space(3)))
typedef unsigned short bf16_t;
typedef short bf16x8 __attribute__((ext_vector_type(8)));
typedef float f32x4 __attribute__((ext_vector_type(4)));
typedef unsigned u32x4 __attribute__((ext_vector_type(4)));
constexpr int BM = 256, BK = 64, HALF = 128, HTB = HALF * BK * 2  , STAGE_BYTES = 8 * HTB, NXCD = 8, WGM = 8;

__host__ __device__ __forceinline__ int lds_byte(int r, int c) { const int st = (r >> 4) * 2 + (c >> 5), rr = r & 15, cc = c & 31, ob = rr * 64 + cc * 2; return st * 1024 + (ob ^ (((ob >> 9) & 1) << 5)); }
__host__ __device__ __forceinline__ void stage_rc(int b, int& R, int& C) { const int st = b / 1024, sb = b % 1024, swz = sb ^ (((sb >> 9) & 1) << 5); R = (st >> 1) * 16 + swz / 64; C = (st & 1) * 32 + (swz % 64) / 2; }
__host__ __device__ __forceinline__ int perm32(int rho) { const int n = rho >> 4, i = rho & 15; return 8 * (i >> 2) + 4 * n + (i & 3); }

struct Unit { int pm, pn; };
struct Gemm { const bf16_t* A; const bf16_t* Bt; int M, N, K; };

struct StaticOrder {
    int nM, nN, nwg, G, c;
    __host__ __device__ void init(int M, int N, int G_, int c_) { nM = M / BM; nN = N / BM; nwg = nM * nN; G = G_; c = c_; }
    __host__ __device__ bool next(int i, Unit& u) const {
        const long L = (long)i * G + c; if (L >= nwg) return false;
        int wgid = (int)L; { const int q = nwg / NXCD, r = nwg % NXCD, xcd = wgid % NXCD, off = wgid / NXCD; wgid = (xcd < r ? xcd * (q + 1) : r * (q + 1) + (xcd - r) * q) + off; }
        const int nig = WGM * nN, gid = wgid / nig, fm = gid * WGM, gsz = (nM - fm) < WGM ? (nM - fm) : WGM;
        u.pm = fm + ((wgid % nig) % gsz); u.pn = (wgid % nig) / gsz; return true;
    }
    __device__ __forceinline__ void a_ready(const Unit&) const {}
    __device__ __forceinline__ void done(const Unit&) const {}
};

__device__ __forceinline__ unsigned cvt_pk_bf16(float lo, float hi) { typedef float f2 __attribute__((ext_vector_type(2))); typedef __bf16 b2 __attribute__((ext_vector_type(2))); f2 v = {lo, hi}; b2 b = __builtin_convertvector(v, b2); return __builtin_bit_cast(unsigned, b); }
__device__ __forceinline__ float bflo(unsigned w) { return __uint_as_float(w << 16); }
__device__ __forceinline__ float bfhi(unsigned w) { return __uint_as_float(w & 0xffff0000u); }
template <class Epi, class Sched, bool ALIGN_EPI = false, bool SP2 = false>
__device__ __forceinline__ void gemm_phase(PG8_LAS unsigned char* lds, const Gemm g, const Sched& S, const Epi& E) {
    const int tid = threadIdx.x, wid = __builtin_amdgcn_readfirstlane(tid >> 6), lane = tid & 63, wr = wid >> 2, wc = wid & 3, fr = lane & 15, fq = lane >> 4;
    const int K = g.K, nt = K / BK;
    unsigned voffA[2], voffB[2];
#pragma unroll
    for (int i = 0; i < 2; ++i) { int R, C; stage_rc(tid * 16 + i * 8192, R, C); const int Rb = Epi::PERM ? ((R & ~31) + perm32(R & 31)) : R;
        voffA[i] = (unsigned)(R * K + C) * 2u; voffB[i] = (unsigned)(Rb * K + C) * 2u; }
    const size_t kstep = (size_t)(BK * 2);
    const size_t hstep = (size_t)HALF * K * 2;
    const size_t tstep = 2 * hstep;
    const unsigned ldsw = (unsigned)wid * 1024u;
    const int aoff = lds_byte(wr * 64 + fr, fq * 8), boff = lds_byte(wc * 32 + fr, fq * 8);
#define PG8_SA(b, h) (((b) * 2 + (h)) * HTB)
#define PG8_SB(b, h) ((4 + (b) * 2 + (h)) * HTB)
#define PG8_STAGE(bufoff, gbase, voff) do { _Pragma("unroll") for (int _i = 0; _i < 2; ++_i) \
        __builtin_amdgcn_global_load_lds((const unsigned*)((const char*)(gbase) + (voff)[_i]), (PG8_LAS unsigned*)(lds + (bufoff) + ldsw + _i * 8192), 16, 0, 0); } while (0)
#define PG8_LDA(dst, b, h) do { _Pragma("unroll") for (int m = 0; m < 4; ++m) _Pragma("unroll") for (int k = 0; k < 2; ++k) dst[m][k] = *(const PG8_LAS bf16x8*)(lds + PG8_SA(b, h) + aoff + m * 2048 + k * 1024); } while (0)
#define PG8_LDB(dst, b, h) do { _Pragma("unroll") for (int n = 0; n < 2; ++n) _Pragma("unroll") for (int k = 0; k < 2; ++k) dst[n][k] = *(const PG8_LAS bf16x8*)(lds + PG8_SB(b, h) + boff + n * 2048 + k * 1024); } while (0)
#define PG8_MMA(ai, bj, At, Bt) do { __builtin_amdgcn_s_setprio(1); _Pragma("unroll") for (int m = 0; m < 4; ++m) _Pragma("unroll") for (int n = 0; n < 2; ++n) _Pragma("unroll") for (int k = 0; k < 2; ++k) \
        acc[ai][bj][m][n] = __builtin_amdgcn_mfma_f32_16x16x32_bf16(Bt[n][k], At[m][k], acc[ai][bj][m][n], 0, 0, 0); __builtin_amdgcn_s_setprio(0); } while (0)
#define PG8_WAIT_V(n) asm volatile("s_waitcnt vmcnt(" #n ")" ::: "memory")
#define PG8_WAIT_L(n) asm volatile("s_waitcnt lgkmcnt(" #n ")" ::: "memory")
#define PG8_BAR __builtin_amdgcn_s_barrier()
#define PG8_SCHED __builtin_amdgcn_sched_barrier(0)
    Unit cur, nxt; int ui = 0;
    if (!S.next(0, cur)) return;
    f32x4 acc[2][2][4][2];
#pragma unroll
    for (int a = 0; a < 2; ++a)
#pragma unroll
        for (int b = 0; b < 2; ++b)
#pragma unroll
            for (int m = 0; m < 4; ++m)
#pragma unroll
                for (int n = 0; n < 2; ++n) acc[a][b][m][n] = (f32x4){0.f, 0.f, 0.f, 0.f};
    bf16x8 At[4][2], B0[2][2], B1[2][2];
    const char* cA = (const char*)g.A + (size_t)cur.pm * tstep; const char* cB = (const char*)g.Bt + (size_t)cur.pn * tstep;
    S.a_ready(cur);
    if constexpr (SP2) {
        PG8_STAGE(PG8_SB(0, 0), cB, voffB); PG8_STAGE(PG8_SB(0, 1), cB + hstep, voffB); PG8_STAGE(PG8_SA(0, 0), cA, voffA); PG8_STAGE(PG8_SA(0, 1), cA + hstep, voffA);
        if (wr == 1) PG8_BAR;
        PG8_WAIT_V(2); PG8_BAR;
        PG8_STAGE(PG8_SB(1, 0), cB + kstep, voffB); PG8_STAGE(PG8_SA(1, 0), cA + kstep, voffA); PG8_STAGE(PG8_SB(1, 1), cB + hstep + kstep, voffB);
        PG8_WAIT_V(6); PG8_BAR;
    } else {
        PG8_STAGE(PG8_SB(0, 0), cB, voffB); PG8_STAGE(PG8_SA(0, 0), cA, voffA); PG8_STAGE(PG8_SB(0, 1), cB + hstep, voffB); PG8_STAGE(PG8_SA(0, 1), cA + hstep, voffA);
        if (wr == 1) PG8_BAR;
        PG8_WAIT_V(4); PG8_BAR;
        PG8_STAGE(PG8_SB(1, 0), cB + kstep, voffB); PG8_STAGE(PG8_SA(1, 0), cA + kstep, voffA); PG8_STAGE(PG8_SB(1, 1), cB + hstep + kstep, voffB);
        PG8_WAIT_V(6); PG8_BAR;
    }
    for (;;) {
        const bool has_next = S.next(ui + 1, nxt);
        const char* nA = has_next ? (const char*)g.A + (size_t)nxt.pm * tstep : cA; const char* nB = has_next ? (const char*)g.Bt + (size_t)nxt.pn * tstep : cB;
        for (int t = 0; t < nt; t += 2) {
            const bool last = (t == nt - 2);
            const char* a1 = cA + (size_t)(t + 1) * kstep;
            const char* a2 = last ? nA : cA + (size_t)(t + 2) * kstep; const char* b2 = last ? nB : cB + (size_t)(t + 2) * kstep;
            const char* a3 = a2 + kstep; const char* b3 = b2 + kstep;
            if (last && has_next) S.a_ready(nxt);
            if constexpr (SP2) {
            PG8_LDB(B0, 0, 0); PG8_LDB(B1, 0, 1); PG8_SCHED; PG8_LDA(At, 0, 0); PG8_STAGE(PG8_SA(1, 1), a1 + hstep, voffA);
            PG8_WAIT_V(8); PG8_WAIT_L(0); PG8_BAR; PG8_MMA(0, 0, At, B0); PG8_MMA(0, 1, At, B1); PG8_BAR; PG8_SCHED;
            PG8_LDA(At, 0, 1); PG8_STAGE(PG8_SB(0, 0), b2, voffB); PG8_STAGE(PG8_SB(0, 1), b2 + hstep, voffB); PG8_STAGE(PG8_SA(0, 0), a2, voffA);
            PG8_WAIT_V(8); PG8_WAIT_L(0); PG8_BAR; PG8_MMA(1, 0, At, B0); PG8_MMA(1, 1, At, B1); PG8_BAR; PG8_SCHED;
            PG8_LDB(B0, 1, 0); PG8_LDB(B1, 1, 1); PG8_SCHED; PG8_LDA(At, 1, 0); PG8_STAGE(PG8_SA(0, 1), a2 + hstep, voffA);
            PG8_WAIT_V(8); PG8_WAIT_L(0); PG8_BAR; PG8_MMA(0, 0, At, B0); PG8_MMA(0, 1, At, B1); PG8_BAR; PG8_SCHED;
            PG8_LDA(At, 1, 1); PG8_STAGE(PG8_SB(1, 0), b3, voffB); PG8_STAGE(PG8_SB(1, 1), b3 + hstep, voffB); PG8_STAGE(PG8_SA(1, 0), a3, voffA);
            PG8_WAIT_V(8); PG8_WAIT_L(0); PG8_BAR; PG8_MMA(1, 0, At, B0); PG8_MMA(1, 1, At, B1); PG8_BAR; PG8_SCHED;
            } else {
            PG8_LDB(B0, 0, 0); PG8_SCHED; PG8_LDA(At, 0, 0); PG8_STAGE(PG8_SA(1, 1), a1 + hstep, voffA);
            PG8_WAIT_L(8); PG8_BAR; PG8_WAIT_L(0); PG8_MMA(0, 0, At, B0); PG8_BAR; PG8_SCHED;
            PG8_LDB(B1, 0, 1); PG8_STAGE(PG8_SB(0, 0), b2, voffB);
            PG8_BAR; PG8_WAIT_L(0); PG8_MMA(0, 1, At, B1); PG8_BAR;
            PG8_LDA(At, 0, 1); PG8_STAGE(PG8_SA(0, 0), a2, voffA);
            PG8_BAR; PG8_WAIT_L(0); PG8_MMA(1, 0, At, B0); PG8_BAR; PG8_SCHED;
            PG8_STAGE(PG8_SB(0, 1), b2 + hstep, voffB);
            PG8_WAIT_V(6); PG8_BAR; PG8_MMA(1, 1, At, B1); PG8_BAR;
            PG8_LDB(B0, 1, 0); PG8_SCHED; PG8_LDA(At, 1, 0); PG8_STAGE(PG8_SA(0, 1), a2 + hstep, voffA);
            PG8_WAIT_L(8); PG8_BAR; PG8_WAIT_L(0); PG8_MMA(0, 0, At, B0); PG8_BAR; PG8_SCHED;
            PG8_LDB(B1, 1, 1); PG8_STAGE(PG8_SB(1, 0), b3, voffB);
            PG8_BAR; PG8_WAIT_L(0); PG8_MMA(0, 1, At, B1); PG8_BAR;
            PG8_LDA(At, 1, 1); PG8_STAGE(PG8_SA(1, 0), a3, voffA);
            PG8_BAR; PG8_WAIT_L(0); PG8_MMA(1, 0, At, B0); PG8_BAR; PG8_SCHED;
            PG8_STAGE(PG8_SB(1, 1), b3 + hstep, voffB);
            PG8_WAIT_V(6); PG8_BAR; PG8_MMA(1, 1, At, B1); PG8_BAR;
            }
        }
        if constexpr (ALIGN_EPI) { if (wr == 0) PG8_BAR; }
        if constexpr (!Epi::AFTER_DRAIN) { E(acc, cur, wr, wc, fr, fq); S.done(cur); }
        if (!has_next) break;
#pragma unroll
        for (int a = 0; a < 2; ++a)
#pragma unroll
            for (int b = 0; b < 2; ++b)
#pragma unroll
                for (int m = 0; m < 4; ++m)
#pragma unroll
                    for (int n = 0; n < 2; ++n) acc[a][b][m][n] = (f32x4){0.f, 0.f, 0.f, 0.f};
        cur = nxt; cA = nA; cB = nB; ++ui;
        if constexpr (ALIGN_EPI) { if (wr == 1) PG8_BAR; }
    }
    PG8_WAIT_V(0);
    if constexpr (!ALIGN_EPI) { if (wr == 0) PG8_BAR; }
    PG8_BAR;
    if constexpr (Epi::AFTER_DRAIN) { E.fused(acc, cur, wr, wc, fr, fq, lds, wid, lane); S.done(cur); }
#undef PG8_SA
#undef PG8_SB
#undef PG8_STAGE
#undef PG8_LDA
#undef PG8_LDB
#undef PG8_MMA
#undef PG8_WAIT_V
#undef PG8_WAIT_L
#undef PG8_BAR
#undef PG8_SCHED
}
}

#define DI __device__ __forceinline__
#define LAS __attribute__((address_space(3)))
typedef unsigned short bf16_t;
typedef short bf16x8 __attribute__((ext_vector_type(8)));
typedef short s16x4 __attribute__((ext_vector_type(4)));
typedef float f32x4 __attribute__((ext_vector_type(4)));
typedef float f32x16 __attribute__((ext_vector_type(16)));
typedef unsigned u32x4 __attribute__((ext_vector_type(4)));
typedef unsigned u32x2 __attribute__((ext_vector_type(2)));
using pg8::cvt_pk_bf16; using pg8::bflo; using pg8::bfhi;
#define MFMA32(a, b, c) __builtin_amdgcn_mfma_f32_32x32x16_bf16((a), (b), (c), 0, 0, 0)

constexpr int DM = 1024, SEQ = 4096, NB = 8, NP = NB * SEQ, NS = 128, NTOK = NP + NS, MP = 33024;
constexpr int DFF = 2816, PD = 256, INW = 6408, NZ = 6400;
constexpr int NSC = 16;
constexpr float LN_EPS = 1e-5f, RMS_EPS = 1e-6f;
constexpr float ALPHA = 1.189207115002721f;
constexpr float LOG2E = 1.4426950408889634f;
constexpr float C2 = 0.125f * 1.4426950408889634f;
constexpr float KSCALE = 0.08838834764831845f;

constexpr size_t MiB = 1u << 20;
constexpr size_t RB = (size_t)MP * 1024 * 2;
constexpr size_t WS_WIN = 1 * MiB;
constexpr size_t WS_WOUT = WS_WIN + (size_t)NZ * 1024 * 2;
constexpr size_t WS_WGU = WS_WOUT + (size_t)1024 * 1024 * 2;
constexpr size_t WS_WDN = WS_WGU + (size_t)2 * DFF * 1024 * 2;
constexpr size_t WS_WPLE = WS_WDN + (size_t)1024 * DFF * 2;
constexpr size_t WS_WPG = WS_WPLE + (size_t)1024 * PD * 2;
constexpr size_t WS_WEND = WS_WPG + (size_t)1024 * 1024 * 2;
constexpr size_t WS_GT = 36 * MiB;
constexpr size_t WS_SM = 38 * MiB;
constexpr size_t SM_G = 0, SM_MLOC = 2048, SM_MST = 4096, SM_NST = 8192, SM_DN = SM_NST + 32 * 16 * 128 * 4;
constexpr size_t WS_XN = 40 * MiB;
constexpr size_t WS_QK = WS_XN + RB, WS_MV = WS_QK + RB, WS_MO = WS_MV + RB, WS_AQ = WS_MO + RB, WS_AKV = WS_AQ + RB;
constexpr size_t WS_GM = WS_AKV + RB / 4, WS_GA = WS_GM + RB, WS_END = WS_GA + RB;
constexpr size_t WS_U1 = WS_QK, WS_X1 = WS_MO, WS_ACT = WS_AQ, WS_PB = WS_AQ + 3 * RB, WS_T1 = WS_QK, WS_PLE = WS_XN;
static_assert(WS_WEND <= WS_GT && WS_GT + (size_t)MP * 32 <= WS_SM && WS_SM + SM_DN + 32 * 16 * 128 * 4 <= WS_XN, "ws map");
static_assert(WS_PB + RB / 4 == WS_END && WS_ACT + (size_t)MP * DFF * 2 <= WS_PB, "ws overlay map");
constexpr size_t O_Y = 0, O_CP = (size_t)NTOK * 1024, O_NP = O_CP + 8 * 4 * 128 * 256, O_MP = O_NP + 8 * 4 * 128, O_CONVP = O_MP + 32;
constexpr size_t O_KP = O_CONVP + 8 * 3 * 1024, O_VP = O_KP + 8 * 128 * 128, O_CS = O_VP + 8 * 128 * 128, O_NS = O_CS + (size_t)128 * 4 * 128 * 256;
constexpr size_t O_MS = O_NS + 128 * 4 * 128, O_CONVS = O_MS + 512, O_KS = O_CONVS + 128 * 3 * 1024, O_VS = O_KS + (size_t)128 * 128 * 128, O_END = O_VS + (size_t)128 * 128 * 128;
constexpr size_t O_DC = 0, O_CST = (size_t)32 * 16 * 32768;

constexpr int LDS_BYTES = 159744;

DI int crow(int reg, int h) { return (reg & 3) + 8 * (reg >> 2) + 4 * h; }
DI float wave_sum(float v) {
#pragma unroll
    for (int o = 1; o < 64; o <<= 1) v += __shfl_xor(v, o);
    return v;
}
DI float sigmoidf_(float x) { return __builtin_amdgcn_rcpf(1.f + __expf(-x)); }
DI float siluf_(float x) { return x * sigmoidf_(x); }
DI void unpack8(const u32x4 w, float (&x)[8]) { x[0] = bflo(w.x); x[1] = bfhi(w.x); x[2] = bflo(w.y); x[3] = bfhi(w.y); x[4] = bflo(w.z); x[5] = bfhi(w.z); x[6] = bflo(w.w); x[7] = bfhi(w.w); }
DI u32x4 pack8(const float (&x)[8]) { u32x4 w; w.x = cvt_pk_bf16(x[0], x[1]); w.y = cvt_pk_bf16(x[2], x[3]); w.z = cvt_pk_bf16(x[4], x[5]); w.w = cvt_pk_bf16(x[6], x[7]); return w; }
DI unsigned short bf1(float x) { return (unsigned short)(cvt_pk_bf16(x, 0.f) & 0xffffu); }
#define LDS_WAIT() asm volatile("s_waitcnt lgkmcnt(0)" ::: "memory")

namespace epi {
using pg8::Unit;
typedef pg8::f32x4 A4;
struct EpiZ {
    static constexpr bool PERM = true, AFTER_DRAIN = false;
    unsigned char* ws;
    DI void operator()(const A4 (&acc)[2][2][4][2], const Unit& u, int wr, int wc, int fr, int fq) const {
        const int pn = u.pn; size_t off; int ldc = 1024, ct; float sc = 1.f;
        if (pn < 4) { off = WS_QK; ct = pn; } else if (pn < 8) { off = WS_MV; ct = pn - 4; } else if (pn < 12) { off = WS_MO; ct = pn - 8; }
        else if (pn < 16) { off = WS_AQ; ct = pn - 12; sc = C2; } else if (pn == 16) { off = WS_AKV; ct = 0; ldc = 256; }
        else if (pn < 21) { off = WS_GM; ct = pn - 17; } else { off = WS_GA; ct = pn - 21; }
        bf16_t* base = (bf16_t*)(ws + off);
        const int row0 = u.pm * 256 + wr * 64 + fr, col0 = ct * 256 + wc * 32 + 8 * fq;
#pragma unroll
        for (int ai = 0; ai < 2; ++ai)
#pragma unroll
            for (int m = 0; m < 4; ++m) { bf16_t* rowp = base + (size_t)(row0 + ai * 128 + m * 16) * ldc + col0;
#pragma unroll
                for (int bj = 0; bj < 2; ++bj) { const A4 v0 = acc[ai][bj][m][0] * sc, v1 = acc[ai][bj][m][1] * sc; u32x4 w;
                    w.x = cvt_pk_bf16(v0[0], v0[1]); w.y = cvt_pk_bf16(v0[2], v0[3]); w.z = cvt_pk_bf16(v1[0], v1[1]); w.w = cvt_pk_bf16(v1[2], v1[3]);
                    *(u32x4*)(rowp + bj * 128) = w; } }
    }
};
struct EpiT1 {
    static constexpr bool PERM = true, AFTER_DRAIN = false;
    bf16_t* O;
    DI void operator()(const A4 (&acc)[2][2][4][2], const Unit& u, int wr, int wc, int fr, int fq) const {
        const int row0 = u.pm * 256 + wr * 64 + fr, col0 = u.pn * 256 + wc * 32 + 8 * fq;
#pragma unroll
        for (int ai = 0; ai < 2; ++ai)
#pragma unroll
            for (int m = 0; m < 4; ++m) { bf16_t* rowp = O + (size_t)(row0 + ai * 128 + m * 16) * 1024 + col0;
#pragma unroll
                for (int bj = 0; bj < 2; ++bj) { const A4 v0 = acc[ai][bj][m][0], v1 = acc[ai][bj][m][1]; u32x4 w;
                    w.x = cvt_pk_bf16(v0[0], v0[1]); w.y = cvt_pk_bf16(v0[2], v0[3]); w.z = cvt_pk_bf16(v1[0], v1[1]); w.w = cvt_pk_bf16(v1[2], v1[3]);
                    *(u32x4*)(rowp + bj * 128) = w; } }
    }
};
struct EpiPLE {
    static constexpr bool PERM = true, AFTER_DRAIN = false;
    const bf16_t* T1; bf16_t* O;
    DI void operator()(const A4 (&acc)[2][2][4][2], const Unit& u, int wr, int wc, int fr, int fq) const {
        const int row0 = u.pm * 256 + wr * 64 + fr, col0 = u.pn * 256 + wc * 32 + 8 * fq;
#pragma unroll
        for (int ai = 0; ai < 2; ++ai)
#pragma unroll
            for (int m = 0; m < 4; ++m) { const size_t ro = (size_t)(row0 + ai * 128 + m * 16) * 1024 + col0;
#pragma unroll
                for (int bj = 0; bj < 2; ++bj) { const A4 v0 = acc[ai][bj][m][0], v1 = acc[ai][bj][m][1];
                    float t[8]; unpack8(*(const u32x4*)(T1 + ro + bj * 128), t); float o[8];
#pragma unroll
                    for (int i = 0; i < 4; ++i) { o[i] = sigmoidf_(v0[i]) * t[i]; o[4 + i] = sigmoidf_(v1[i]) * t[4 + i]; }
                    *(u32x4*)(O + ro + bj * 128) = pack8(o); } }
    }
};
struct EpiU1 {
    static constexpr bool PERM = true, AFTER_DRAIN = false;
    const bf16_t* XN; float* O;
    DI void operator()(const A4 (&acc)[2][2][4][2], const Unit& u, int wr, int wc, int fr, int fq) const {
        const int row0 = u.pm * 256 + wr * 64 + fr, col0 = u.pn * 256 + wc * 32 + 8 * fq;
#pragma unroll
        for (int ai = 0; ai < 2; ++ai)
#pragma unroll
            for (int m = 0; m < 4; ++m) { const size_t ro = (size_t)(row0 + ai * 128 + m * 16) * 1024 + col0;
#pragma unroll
                for (int bj = 0; bj < 2; ++bj) { const A4 v0 = acc[ai][bj][m][0], v1 = acc[ai][bj][m][1];
                    float t[8]; unpack8(*(const u32x4*)(XN + ro + bj * 128), t);
                    A4 o0, o1;
#pragma unroll
                    for (int i = 0; i < 4; ++i) { o0[i] = ALPHA * t[i] + v0[i]; o1[i] = ALPHA * t[4 + i] + v1[i]; }
                    *(A4*)(O + ro + bj * 128) = o0; *(A4*)(O + ro + bj * 128 + 4) = o1; } }
    }
};
struct EpiGU {
    static constexpr bool PERM = true, AFTER_DRAIN = false;
    bf16_t* O;
    DI void operator()(const A4 (&acc)[2][2][4][2], const Unit& u, int wr, int wc, int fr, int fq) const {
        const int row0 = u.pm * 256 + wr * 64 + fr, col0 = u.pn * 128 + wc * 32 + 8 * fq;
#pragma unroll
        for (int ai = 0; ai < 2; ++ai)
#pragma unroll
            for (int m = 0; m < 4; ++m) { bf16_t* rowp = O + (size_t)(row0 + ai * 128 + m * 16) * DFF + col0;
                const A4 g0 = acc[ai][0][m][0], g1 = acc[ai][0][m][1], u0 = acc[ai][1][m][0], u1 = acc[ai][1][m][1]; float o[8];
#pragma unroll
                for (int i = 0; i < 4; ++i) { o[i] = siluf_(g0[i]) * u0[i]; o[4 + i] = siluf_(g1[i]) * u1[i]; }
                *(u32x4*)rowp = pack8(o); }
    }
};
struct EpiDN {
    static constexpr bool PERM = true, AFTER_DRAIN = false;
    const bf16_t* X1; const bf16_t* PLE; float* O;
    DI void operator()(const A4 (&acc)[2][2][4][2], const Unit& u, int wr, int wc, int fr, int fq) const {
        const int row0 = u.pm * 256 + wr * 64 + fr, col0 = u.pn * 256 + wc * 32 + 8 * fq;
#pragma unroll
        for (int ai = 0; ai < 2; ++ai)
#pragma unroll
            for (int m = 0; m < 4; ++m) { const int row = row0 + ai * 128 + m * 16; const size_t ro = (size_t)row * 1024 + col0;
                if (row < NTOK) {
#pragma unroll
                for (int bj = 0; bj < 2; ++bj) { const A4 v0 = acc[ai][bj][m][0], v1 = acc[ai][bj][m][1];
                    float t[8], p[8]; unpack8(*(const u32x4*)(X1 + ro + bj * 128), t); unpack8(*(const u32x4*)(PLE + ro + bj * 128), p);
                    A4 o0, o1;
#pragma unroll
                    for (int i = 0; i < 4; ++i) { o0[i] = ALPHA * t[i] + v0[i] + p[i]; o1[i] = ALPHA * t[4 + i] + v1[i] + p[4 + i]; }
                    *(A4*)(O + ro + bj * 128) = o0; *(A4*)(O + ro + bj * 128 + 4) = o1; } } }
    }
};
}

struct Args { const float* in[28]; float* out; unsigned char* ws; };
struct Frame {
    LAS unsigned char* lds; int tid, lane, wave, G, bid;
    float* out; unsigned char* ws;
};
DI const float* inptr(int i) { int off = 8 * i; asm volatile("" : "+s"(off)); return *(const float* const*)((const unsigned char*)__builtin_amdgcn_kernarg_segment_ptr() + off); }
#define IN_XP 0
#define IN_XS 1
#define IN_C0 2
#define IN_N0 3
#define IN_M0 4
#define IN_CONV0 5
#define IN_CK 6
#define IN_CV 7
#define IN_PP 8
#define IN_PS 9
#define IN_LNG 10
#define IN_LNB 11
#define IN_WIN 12
#define IN_BI 13
#define IN_BF 14
#define IN_CW 15
#define IN_CB 16
#define IN_MNG 17
#define IN_SINK 18
#define IN_WOUT 19
#define IN_LN1G 20
#define IN_LN1B 21
#define IN_WGU 22
#define IN_WDN 23
#define IN_LN2G 24
#define IN_LN2B 25
#define IN_WPLE 26
#define IN_WPG 27

DI void p0_transpose_item(const float* W, int ldw, int src_col0, bf16_t* WT, int K, int dst_row0, int k0, LAS float* scr, int lane) {
#pragma unroll 8
    for (int i = 0; i < 32; ++i) { const int kk = 2 * i + (lane >> 5); scr[kk * 33 + (lane & 31)] = W[(size_t)(k0 + kk) * ldw + src_col0 + (lane & 31)]; }
    LDS_WAIT();
    const int c = lane & 7;
#pragma unroll
    for (int j = 0; j < 4; ++j) { const int n = (lane >> 3) + 8 * j; const LAS float* s = scr + (8 * c) * 33 + n;
        u32x4 o; o.x = cvt_pk_bf16(s[0 * 33], s[1 * 33]); o.y = cvt_pk_bf16(s[2 * 33], s[3 * 33]); o.z = cvt_pk_bf16(s[4 * 33], s[5 * 33]); o.w = cvt_pk_bf16(s[6 * 33], s[7 * 33]);
        *(u32x4*)(WT + (size_t)(dst_row0 + n) * K + k0 + 8 * c) = o; }
    LDS_WAIT();
}
DI void p0_prologue(Frame& F) {
    LAS float* wgT = (LAS float*)(F.lds + 73728);
    for (int idx = F.tid; idx < 8192; idx += 512) { const int c = idx & 7, k = idx >> 3; wgT[c * 1024 + k] = inptr(IN_WIN)[(size_t)k * INW + 2048 + c]; }
    LAS float* scr = (LAS float*)(F.lds + F.wave * 8704);
    const int gw = F.bid * 8 + F.wave, NGW = F.G * 8;
    bf16_t* Win_t = (bf16_t*)(F.ws + WS_WIN); bf16_t* Wout_t = (bf16_t*)(F.ws + WS_WOUT); bf16_t* Wgu_t = (bf16_t*)(F.ws + WS_WGU);
    bf16_t* Wdn_t = (bf16_t*)(F.ws + WS_WDN); bf16_t* Wple_t = (bf16_t*)(F.ws + WS_WPLE); bf16_t* Wpg_t = (bf16_t*)(F.ws + WS_WPG);
    constexpr int I_IN = 16 * 200, I_OUT = 16 * 32, I_GU = 16 * 176, I_DN = 44 * 32, I_PLE = 4 * 32, I_PG = 16 * 32;
    constexpr int NITEMS = I_IN + I_OUT + I_GU + I_DN + I_PLE + I_PG;
    for (int it = gw; it < NITEMS; it += NGW) {
        int r = it;
        if (r < I_IN) { const int kb = r / 200, n0 = 32 * (r % 200); p0_transpose_item(inptr(IN_WIN), INW, n0 + (n0 >= 2048 ? 8 : 0), Win_t, 1024, n0, 64 * kb, scr, F.lane); continue; } r -= I_IN;
        if (r < I_OUT) { const int kb = r / 32, n0 = 32 * (r % 32); p0_transpose_item(inptr(IN_WOUT), 1024, n0, Wout_t, 1024, n0, 64 * kb, scr, F.lane); continue; } r -= I_OUT;
        if (r < I_GU) { const int kb = r / 176, n0 = 32 * (r % 176); const int pn = n0 >> 8, rr = n0 & 255; const int src = rr < 128 ? 128 * pn + rr : DFF + 128 * pn + rr - 128;
            p0_transpose_item(inptr(IN_WGU), 2 * DFF, src, Wgu_t, 1024, n0, 64 * kb, scr, F.lane); continue; } r -= I_GU;
        if (r < I_DN) { const int kb = r / 32, n0 = 32 * (r % 32); p0_transpose_item(inptr(IN_WDN), 1024, n0, Wdn_t, DFF, n0, 64 * kb, scr, F.lane); continue; } r -= I_DN;
        if (r < I_PLE) { const int kb = r / 32, n0 = 32 * (r % 32); p0_transpose_item(inptr(IN_WPLE), 1024, n0, Wple_t, PD, n0, 64 * kb, scr, F.lane); continue; } r -= I_PLE;
        { const int kb = r / 32, n0 = 32 * (r % 32); p0_transpose_item(inptr(IN_WPG), 1024, n0, Wpg_t, 1024, n0, 64 * kb, scr, F.lane); }
    }
    __syncthreads();
    bf16_t* XN = (bf16_t*)(F.ws + WS_XN); float* GT = (float*)(F.ws + WS_GT);
    f32x4 g4[4], b4[4];
#pragma unroll
    for (int j = 0; j < 4; ++j) { g4[j] = *(const f32x4*)(inptr(IN_LNG) + 4 * F.lane + 256 * j); b4[j] = *(const f32x4*)(inptr(IN_LNB) + 4 * F.lane + 256 * j); }
    const float gbias = F.lane < 4 ? inptr(IN_BI)[F.lane] : (F.lane < 8 ? inptr(IN_BF)[F.lane - 4] : 0.f);
    for (int m = gw; m < MP; m += NGW) {
        unsigned long long* o8 = (unsigned long long*)(XN + (size_t)m * 1024) + F.lane;
        if (m >= NTOK) {
#pragma unroll
            for (int j = 0; j < 4; ++j) o8[64 * j] = 0ull;
            if (F.lane < 8) GT[(size_t)m * 8 + F.lane] = 0.f;
            continue;
        }
        const float* src = m < NP ? inptr(IN_XP) + (size_t)m * 1024 : inptr(IN_XS) + (size_t)(m - NP) * 1024;
        f32x4 v[4]; float s = 0.f;
#pragma unroll
        for (int j = 0; j < 4; ++j) { v[j] = *(const f32x4*)(src + 4 * F.lane + 256 * j); s += (v[j].x + v[j].y) + (v[j].z + v[j].w); }
        const float mean = wave_sum(s) * (1.f / 1024.f); float s2 = 0.f;
#pragma unroll
        for (int j = 0; j < 4; ++j) { v[j] = v[j] - mean; s2 += (v[j].x * v[j].x + v[j].y * v[j].y) + (v[j].z * v[j].z + v[j].w * v[j].w); }
        const float rstd = 1.f / sqrtf(wave_sum(s2) * (1.f / 1024.f) + LN_EPS);
#pragma unroll
        for (int j = 0; j < 4; ++j) { v[j] = v[j] * rstd * g4[j] + b4[j];
            o8[64 * j] = (unsigned long long)cvt_pk_bf16(v[j].x, v[j].y) | ((unsigned long long)cvt_pk_bf16(v[j].z, v[j].w) << 32); }
        float mine = 0.f;
#pragma unroll
        for (int c = 0; c < 8; ++c) { float a = 0.f;
#pragma unroll
            for (int j = 0; j < 4; ++j) { const f32x4 w = *(const LAS f32x4*)(wgT + c * 1024 + 4 * F.lane + 256 * j); a += (v[j].x * w.x + v[j].y * w.y) + (v[j].z * w.z + v[j].w * w.w); }
            a = wave_sum(a); if (F.lane == c) mine = a; }
        if (F.lane < 8) GT[(size_t)m * 8 + F.lane] = mine + gbias;
    }
}

DI void gate_scan(const float* GT, int b, int h, int j, LAS float* sG, LAS float* sA, LAS float* sM, LAS float* tmp, int tid) {
    float li = 0.f;
    if (tid < 256) { const size_t row = (size_t)b * SEQ + j * 256 + tid; const float f = GT[row * 8 + 4 + h]; li = GT[row * 8 + h];
        tmp[tid] = fminf(f, 0.f) - log1pf(expf(-fabsf(f))); }
    __syncthreads();
    int cur = 0;
    for (int off = 1; off < 256; off <<= 1) {
        if (tid < 256) { float v = tmp[cur * 256 + tid]; if (tid >= off) v += tmp[cur * 256 + tid - off]; tmp[(cur ^ 1) * 256 + tid] = v; }
        __syncthreads(); cur ^= 1;
    }
    float Gv = 0.f, av = 0.f;
    if (tid < 256) { Gv = tmp[cur * 256 + tid]; av = li - Gv; }
    __syncthreads();
    if (tid < 256) { sG[tid] = Gv; sA[tid] = av; tmp[tid] = av; }
    __syncthreads();
    cur = 0;
    for (int off = 1; off < 256; off <<= 1) {
        if (tid < 256) { float v = tmp[cur * 256 + tid]; if (tid >= off) v = fmaxf(v, tmp[cur * 256 + tid - off]); tmp[(cur ^ 1) * 256 + tid] = v; }
        __syncthreads(); cur ^= 1;
    }
    if (tid < 256) sM[tid] = tmp[cur * 256 + tid];
    __syncthreads();
}
DI void conv8(const bf16_t* QK, size_t rowbase, int tseq, int cglob, const LAS float* cwl, int cl, float (&out)[8]) {
    float a[8];
#pragma unroll
    for (int e = 0; e < 8; ++e) a[e] = cwl[4 * 128 + cl + e];
#pragma unroll
    for (int jj = 0; jj < 4; ++jj) { const int tt = tseq - 3 + jj;
        if (tt >= 0) { float x[8]; unpack8(*(const u32x4*)(QK + (rowbase + tt) * 1024 + cglob), x);
#pragma unroll
            for (int e = 0; e < 8; ++e) a[e] += cwl[jj * 128 + cl + e] * x[e]; } }
#pragma unroll
    for (int e = 0; e < 8; ++e) out[e] = siluf_(a[e]);
}
DI void load_convw(const Frame& F, LAS float* cwl, int cbase) {
    for (int idx = F.tid; idx < 640; idx += 512) { const int jj = idx >> 7, c = idx & 127; cwl[idx] = jj < 4 ? inptr(IN_CW)[jj * 1024 + cbase + c] : inptr(IN_CB)[cbase + c]; }
}
DI void stage_vt(const bf16_t* MV, size_t row0, int h, LAS bf16_t* VT, int tid) {
    const int s = tid & 63, vg = tid >> 6;
    const bf16_t* src = MV + (row0 + s) * 1024 + h * 256 + 32 * vg;
#pragma unroll
    for (int q = 0; q < 4; ++q) { const u32x4 w = *(const u32x4*)(src + 8 * q); LAS bf16_t* d = VT + (32 * vg + 8 * q) * 72 + s;
        d[0 * 72] = (bf16_t)(w.x & 0xffff); d[1 * 72] = (bf16_t)(w.x >> 16); d[2 * 72] = (bf16_t)(w.y & 0xffff); d[3 * 72] = (bf16_t)(w.y >> 16);
        d[4 * 72] = (bf16_t)(w.z & 0xffff); d[5 * 72] = (bf16_t)(w.z >> 16); d[6 * 72] = (bf16_t)(w.w & 0xffff); d[7 * 72] = (bf16_t)(w.w >> 16); }
}

DI void mlstm_a_item(Frame& F, int it) {
    const int b = it >> 6, h = (it >> 4) & 3, j = it & 15, bh = b * 4 + h;
    const int tid = F.tid, lane = F.lane, wid = F.wave, r = lane & 31, hh = lane >> 5;
    LAS float* sG = (LAS float*)(F.lds + 0); LAS float* sA = (LAS float*)(F.lds + 1024); LAS float* sM = (LAS float*)(F.lds + 2048);
    LAS float* tmp = (LAS float*)(F.lds + 3072); LAS float* sWs = (LAS float*)(F.lds + 5120); LAS float* cwk = (LAS float*)(F.lds + 6144);
    LAS bf16_t* KWT = (LAS bf16_t*)(F.lds + 16384); LAS bf16_t* VT = (LAS bf16_t*)(F.lds + 34816);
    const float* GT = (const float*)(F.ws + WS_GT); const bf16_t* QK = (const bf16_t*)(F.ws + WS_QK); const bf16_t* MV = (const bf16_t*)(F.ws + WS_MV);
    gate_scan(GT, b, h, j, sG, sA, sM, tmp, tid);
    const float amax = sM[255];
    if (tid < 256) sWs[tid] = expf(sA[tid] - amax) * KSCALE;
    load_convw(F, cwk, 512 + 128 * h);
    __syncthreads();
    f32x16 acc[2][2];
#pragma unroll
    for (int i = 0; i < 2; ++i)
#pragma unroll
        for (int jn = 0; jn < 2; ++jn)
#pragma unroll
            for (int e = 0; e < 16; ++e) acc[i][jn][e] = 0.f;
    float dn = 0.f;
    const int wr = wid >> 2, wc = wid & 3;
    for (int ch = 0; ch < 4; ++ch) {
        { const int s = tid & 63, dg = tid >> 6, tokl = ch * 64 + s, tseq = j * 256 + tokl; const float w = sWs[tokl];
#pragma unroll
            for (int q = 0; q < 2; ++q) { float kc[8]; conv8(QK, (size_t)b * SEQ, tseq, 512 + 128 * h + 16 * dg + 8 * q, cwk, 16 * dg + 8 * q, kc);
#pragma unroll
                for (int e = 0; e < 8; ++e) KWT[(16 * dg + 8 * q + e) * 72 + s] = bf1(kc[e] * w); } }
        stage_vt(MV, (size_t)b * SEQ + j * 256 + ch * 64, h, VT, tid);
        __syncthreads();
#pragma unroll
        for (int ks = 0; ks < 4; ++ks) { bf16x8 a[2], bb[2];
#pragma unroll
            for (int i = 0; i < 2; ++i) a[i] = *(const LAS bf16x8*)(KWT + (wr * 64 + i * 32 + r) * 72 + 16 * ks + 8 * hh);
#pragma unroll
            for (int jn = 0; jn < 2; ++jn) bb[jn] = *(const LAS bf16x8*)(VT + (wc * 64 + jn * 32 + r) * 72 + 16 * ks + 8 * hh);
#pragma unroll
            for (int i = 0; i < 2; ++i)
#pragma unroll
                for (int jn = 0; jn < 2; ++jn) acc[i][jn] = MFMA32(a[i], bb[jn], acc[i][jn]); }
        if (tid < 128) {
#pragma unroll
            for (int q = 0; q < 8; ++q) { float x[8]; unpack8(*(const LAS u32x4*)(KWT + tid * 72 + 8 * q), x);
#pragma unroll
                for (int e = 0; e < 8; ++e) dn += x[e]; } }
        __syncthreads();
    }
    float* dC = F.out + O_DC + ((size_t)bh * 16 + j) * 32768;
#pragma unroll
    for (int i = 0; i < 2; ++i)
#pragma unroll
        for (int jn = 0; jn < 2; ++jn)
#pragma unroll
            for (int e = 0; e < 16; ++e) dC[(size_t)(wr * 64 + i * 32 + crow(e, hh)) * 256 + wc * 64 + jn * 32 + r] = acc[i][jn][e];
    if (tid < 128) ((float*)(F.ws + WS_SM + SM_DN))[(bh * 16 + j) * 128 + tid] = dn;
    if (tid == 0) { ((float*)(F.ws + WS_SM + SM_G))[bh * 16 + j] = sG[255]; ((float*)(F.ws + WS_SM + SM_MLOC))[bh * 16 + j] = amax + sG[255]; }
    __syncthreads();
}

DI void attn_unit(Frame& F, int it) {
    const int b = it >> 7, kvh = (it >> 6) & 1, qt = it & 63, q0 = qt * 64;
    const int tid = F.tid, lane = F.lane, wid = F.wave, r = lane & 31, hh = lane >> 5;
    LAS bf16_t* Kn = (LAS bf16_t*)(F.lds + 0);
    LAS bf16_t* VT = (LAS bf16_t*)(F.lds + 27648);
    LAS bf16_t* stg = (LAS bf16_t*)(F.lds + 53248 + wid * 4608);
    bf16_t* AQ = (bf16_t*)(F.ws + WS_AQ); const bf16_t* AKV = (const bf16_t*)(F.ws + WS_AKV);
    const size_t rowb = (size_t)b * SEQ;
#pragma unroll
    for (int i = 0; i < 3; ++i) { const int id = tid + 512 * i, kk = id >> 3, ch = id & 7, tk = q0 - 128 + kk;
        u32x4 w = (u32x4){0u, 0u, 0u, 0u}; if (tk >= 0) w = *(const u32x4*)(AKV + (rowb + tk) * 256 + kvh * 64 + 8 * ch);
        *(LAS u32x4*)(Kn + kk * 72 + 8 * ch) = w; }
#pragma unroll
    for (int i = 0; i < 3; ++i) { const int id = tid + 512 * i, kk = id % 192, ch = id / 192, tk = q0 - 128 + kk;
        u32x4 w = (u32x4){0u, 0u, 0u, 0u}; if (tk >= 0) w = *(const u32x4*)(AKV + (rowb + tk) * 256 + 128 + kvh * 64 + 8 * ch);
        LAS bf16_t* d = VT + (8 * ch) * 200 + kk;
        d[0 * 200] = (bf16_t)(w.x & 0xffff); d[1 * 200] = (bf16_t)(w.x >> 16); d[2 * 200] = (bf16_t)(w.y & 0xffff); d[3 * 200] = (bf16_t)(w.y >> 16);
        d[4 * 200] = (bf16_t)(w.z & 0xffff); d[5 * 200] = (bf16_t)(w.z >> 16); d[6 * 200] = (bf16_t)(w.w & 0xffff); d[7 * 200] = (bf16_t)(w.w >> 16); }
    __syncthreads();
    const int hq = kvh * 8 + wid;
    const float sink2 = inptr(IN_SINK)[hq] * LOG2E;
    for (int gi = 0; gi < 2; ++gi) {
        const int tq = q0 + 32 * gi;
        bf16x8 qf[4];
#pragma unroll
        for (int ks = 0; ks < 4; ++ks) qf[ks] = *(const bf16x8*)(AQ + (rowb + tq + r) * 1024 + hq * 64 + 16 * ks + 8 * hh);
        f32x16 st[5];
#pragma unroll
        for (int kt = 0; kt < 5; ++kt) {
#pragma unroll
            for (int e = 0; e < 16; ++e) st[kt][e] = 0.f;
#pragma unroll
            for (int ks = 0; ks < 4; ++ks) { const bf16x8 a = *(const LAS bf16x8*)(Kn + (32 * gi + 32 * kt + r) * 72 + 16 * ks + 8 * hh); st[kt] = MFMA32(a, qf[ks], st[kt]); } }
        float mx = -INFINITY;
        if (q0 < 128) {
#pragma unroll
            for (int kt = 0; kt < 5; ++kt) { const int kb = q0 - 128 + 32 * gi + 32 * kt + 4 * hh;
#pragma unroll
                for (int e = 0; e < 16; ++e) if (kb + (e & 3) + 8 * (e >> 2) < 0) st[kt][e] = -INFINITY;
                __builtin_amdgcn_sched_barrier(0); }
        }
#pragma unroll
        for (int e = 0; e < 16; ++e) if (crow(e, hh) < r) st[0][e] = -INFINITY;
        __builtin_amdgcn_sched_barrier(0);
#pragma unroll
        for (int e = 0; e < 16; ++e) if (crow(e, hh) > r) st[4][e] = -INFINITY;
        __builtin_amdgcn_sched_barrier(0);
#pragma unroll
        for (int kt = 0; kt < 5; ++kt)
#pragma unroll
            for (int e = 0; e < 16; ++e) mx = fmaxf(mx, st[kt][e]);
        mx = fmaxf(mx, __shfl_xor(mx, 32)); mx = fmaxf(mx, sink2);
        float sum = 0.f;
#pragma unroll
        for (int kt = 0; kt < 5; ++kt)
#pragma unroll
            for (int e = 0; e < 16; ++e) { const float ev = __builtin_amdgcn_exp2f(st[kt][e] - mx); st[kt][e] = ev; sum += ev; }
        sum += __shfl_xor(sum, 32);
        const float rinv = 1.f / (sum + __builtin_amdgcn_exp2f(sink2 - mx));
        f32x16 o[2];
#pragma unroll
        for (int dn = 0; dn < 2; ++dn)
#pragma unroll
            for (int e = 0; e < 16; ++e) o[dn][e] = 0.f;
#pragma unroll
        for (int kt = 0; kt < 5; ++kt)
#pragma unroll
            for (int s2 = 0; s2 < 2; ++s2) { u32x4 pw;
                pw.x = cvt_pk_bf16(st[kt][8 * s2 + 0] * rinv, st[kt][8 * s2 + 1] * rinv); pw.y = cvt_pk_bf16(st[kt][8 * s2 + 2] * rinv, st[kt][8 * s2 + 3] * rinv);
                pw.z = cvt_pk_bf16(st[kt][8 * s2 + 4] * rinv, st[kt][8 * s2 + 5] * rinv); pw.w = cvt_pk_bf16(st[kt][8 * s2 + 6] * rinv, st[kt][8 * s2 + 7] * rinv);
                const bf16x8 pa = __builtin_bit_cast(bf16x8, pw);
#pragma unroll
                for (int dn = 0; dn < 2; ++dn) { const LAS bf16_t* vp = VT + (dn * 32 + r) * 200 + 32 * gi + 32 * kt + 16 * s2 + 4 * hh;
                    const u32x2 lo = *(const LAS u32x2*)vp, hi = *(const LAS u32x2*)(vp + 8);
                    const u32x4 vb = (u32x4){lo.x, lo.y, hi.x, hi.y};
                    o[dn] = MFMA32(pa, __builtin_bit_cast(bf16x8, vb), o[dn]); } }
#pragma unroll
        for (int dn = 0; dn < 2; ++dn)
#pragma unroll
            for (int e = 0; e < 16; ++e) stg[crow(e, hh) * 72 + dn * 32 + r] = bf1(o[dn][e]);
        LDS_WAIT();
#pragma unroll
        for (int i = 0; i < 4; ++i) { const int id = lane + 64 * i, row = id >> 3, ch = id & 7; const u32x4 v = *(const LAS u32x4*)(stg + row * 72 + 8 * ch);
            *(u32x4*)(AQ + (rowb + tq + row) * 1024 + hq * 64 + 8 * ch) = v; }
        LDS_WAIT();
    }
    __syncthreads();
}

DI void sattn_item(Frame& F, int b) {
    const int tid = F.tid;
    LAS float* Ks = (LAS float*)(F.lds + 0);
    LAS float* Vs = (LAS float*)(F.lds + 66564);
    LAS float* sQ = (LAS float*)(F.lds + 132612);
    LAS float* sP = (LAS float*)(F.lds + 136708);
    bf16_t* AQ = (bf16_t*)(F.ws + WS_AQ); const bf16_t* AKV = (const bf16_t*)(F.ws + WS_AKV);
    const size_t row = (size_t)NP + b;
    const float* ck = inptr(IN_CK) + (size_t)b * 16384; const float* cv = inptr(IN_CV) + (size_t)b * 16384;
    float* ks_o = F.out + O_KS + (size_t)b * 16384; float* vs_o = F.out + O_VS + (size_t)b * 16384;
    for (int idx = tid; idx < 16384; idx += 512) { const int kk = idx >> 7, c = idx & 127; const float kv = ck[idx], vv = cv[idx];
        Ks[kk * 129 + c] = kv; Vs[kk * 128 + c] = vv; if (kk >= 1) { ks_o[idx - 128] = kv; vs_o[idx - 128] = vv; } }
    if (tid < 128) { const float kn = bflo((unsigned)AKV[row * 256 + tid]), vn = bflo((unsigned)AKV[row * 256 + 128 + tid]);
        Ks[128 * 129 + tid] = kn; Vs[128 * 128 + tid] = vn; ks_o[127 * 128 + tid] = kn; vs_o[127 * 128 + tid] = vn; }
    for (int idx = tid; idx < 1024; idx += 512) sQ[idx] = bflo((unsigned)AQ[row * 1024 + idx]);
    __syncthreads();
    const int hq = tid >> 5, l = tid & 31, kvh = hq >> 3;
    { float sc[5]; float mx = -INFINITY;
#pragma unroll
        for (int i = 0; i < 5; ++i) { const int kk = l + 32 * i; float s = -INFINITY;
            if (kk < 129) { s = 0.f;
#pragma unroll 4
                for (int d = 0; d < 64; ++d) s += sQ[hq * 64 + d] * Ks[kk * 129 + kvh * 64 + d]; }
            sc[i] = s; mx = fmaxf(mx, s); asm volatile("" ::: "memory"); }
#pragma unroll
        for (int o = 1; o < 32; o <<= 1) mx = fmaxf(mx, __shfl_xor(mx, o));
        const float sink2 = inptr(IN_SINK)[hq] * LOG2E; mx = fmaxf(mx, sink2);
        float sum = 0.f;
#pragma unroll
        for (int i = 0; i < 5; ++i) { sc[i] = __builtin_amdgcn_exp2f(sc[i] - mx); sum += sc[i]; }
#pragma unroll
        for (int o = 1; o < 32; o <<= 1) sum += __shfl_xor(sum, o);
        const float rinv = 1.f / (sum + __builtin_amdgcn_exp2f(sink2 - mx));
#pragma unroll
        for (int i = 0; i < 5; ++i) { const int kk = l + 32 * i; if (kk < 129) sP[hq * 132 + kk] = sc[i] * rinv; } }
    __syncthreads();
    { float o0 = 0.f, o1 = 0.f;
#pragma unroll 4
        for (int kk = 0; kk < 129; ++kk) { const float p = sP[hq * 132 + kk]; o0 += p * Vs[kk * 128 + kvh * 64 + l]; o1 += p * Vs[kk * 128 + kvh * 64 + 32 + l]; }
        AQ[row * 1024 + hq * 64 + l] = bf1(o0); AQ[row * 1024 + hq * 64 + 32 + l] = bf1(o1); }
    __syncthreads();
}

DI void scan_item(Frame& F, int it) {
    const int bh = it >> 3, sl = it & 7, tid = F.tid;
    const float* g = (const float*)(F.ws + WS_SM + SM_G) + bh * 16; const float* ml = (const float*)(F.ws + WS_SM + SM_MLOC) + bh * 16;
    float fa[16], fb[16], mj[17]; mj[0] = 0.f;
#pragma unroll
    for (int j = 0; j < 16; ++j) { const float gj = g[j], mlj = ml[j]; const float mn = fmaxf(gj + mj[j], mlj); fa[j] = expf(gj + mj[j] - mn); fb[j] = expf(mlj - mn); mj[j + 1] = mn; }
    const float* dC = F.out + O_DC + (size_t)bh * 16 * 32768; float* Cst = F.out + O_CST + (size_t)bh * 16 * 32768; float* Cp = F.out + O_CP + (size_t)bh * 32768;
#pragma unroll
    for (int q = 0; q < 2; ++q) { const int e0 = sl * 4096 + q * 2048 + tid * 4; f32x4 c = (f32x4){0.f, 0.f, 0.f, 0.f};
#pragma unroll
        for (int j = 0; j < 16; ++j) { *(f32x4*)(Cst + (size_t)j * 32768 + e0) = c; const f32x4 d = *(const f32x4*)(dC + (size_t)j * 32768 + e0); c = c * fa[j] + d * fb[j]; }
        *(f32x4*)(Cp + e0) = c; }
    if (sl == 0) {
        float* mst = (float*)(F.ws + WS_SM + SM_MST) + bh * 17;
        if (tid < 17) { float v = mj[0];
#pragma unroll
            for (int j = 1; j < 17; ++j) if (tid == j) v = mj[j];
            mst[tid] = v; if (tid == 16) F.out[O_MP + bh] = v; }
        if (tid < 128) { const float* dn = (const float*)(F.ws + WS_SM + SM_DN) + (size_t)bh * 16 * 128; float* nst = (float*)(F.ws + WS_SM + SM_NST) + (size_t)bh * 16 * 128; float n = 0.f;
#pragma unroll
            for (int j = 0; j < 16; ++j) { nst[j * 128 + tid] = n; n = n * fa[j] + dn[j * 128 + tid] * fb[j]; }
            F.out[O_NP + bh * 128 + tid] = n; }
    }
}

DI void mlstm_c_item(Frame& F, int it) {
    const int b = it >> 6, h = (it >> 4) & 3, j = it & 15, bh = b * 4 + h;
    const int tid = F.tid, lane = F.lane, wid = F.wave, r = lane & 31, hh = lane >> 5;
    LAS float* sG = (LAS float*)(F.lds + 0); LAS float* sA = (LAS float*)(F.lds + 1024); LAS float* sM = (LAS float*)(F.lds + 2048);
    LAS float* tmp = (LAS float*)(F.lds + 3072); LAS float* sU = (LAS float*)(F.lds + 5120); LAS float* cwk = (LAS float*)(F.lds + 6144);
    LAS float* cwq = (LAS float*)(F.lds + 8704); LAS float* sN = (LAS float*)(F.lds + 11264); LAS float* sQN = (LAS float*)(F.lds + 11776);
    LAS float* sRS = (LAS float*)(F.lds + 12032); LAS float* sInter = (LAS float*)(F.lds + 13056); LAS float* sRden = (LAS float*)(F.lds + 13312);
    LAS bf16_t* Qc = (LAS bf16_t*)(F.lds + 16384); LAS bf16_t* Kc = (LAS bf16_t*)(F.lds + 33792); LAS bf16_t* KWT = (LAS bf16_t*)(F.lds + 51200);
    LAS bf16_t* VT = (LAS bf16_t*)(F.lds + 69632); LAS bf16_t* W = (LAS bf16_t*)(F.lds + 106496); LAS float* H = (LAS float*)(F.lds + 16384);
    const float* GT = (const float*)(F.ws + WS_GT); const bf16_t* QK = (const bf16_t*)(F.ws + WS_QK); const bf16_t* MV = (const bf16_t*)(F.ws + WS_MV);
    const bf16_t* MO = (const bf16_t*)(F.ws + WS_MO); const bf16_t* YA = (const bf16_t*)(F.ws + WS_AQ); bf16_t* GM = (bf16_t*)(F.ws + WS_GM); const bf16_t* GA = (const bf16_t*)(F.ws + WS_GA);
    gate_scan(GT, b, h, j, sG, sA, sM, tmp, tid);
    const float m_start = ((const float*)(F.ws + WS_SM + SM_MST))[bh * 17 + j];
    if (tid < 256) sU[tid] = -fmaxf(m_start, sM[tid]);
    load_convw(F, cwk, 512 + 128 * h); load_convw(F, cwq, 128 * h);
    if (tid < 128) sN[tid] = ((const float*)(F.ws + WS_SM + SM_NST))[(bh * 16 + j) * 128 + tid];
    f32x16 Cacc[4];
    { const float* Cst = F.out + O_CST + ((size_t)bh * 16 + j) * 32768;
        const float* cb = Cst + (size_t)(4 * hh) * 256 + 32 * wid + r;
#pragma unroll
        for (int dt = 0; dt < 4; ++dt) {
#pragma unroll
            for (int e = 0; e < 16; ++e) Cacc[dt][e] = cb[(dt * 32 + (e & 3) + 8 * (e >> 2)) * 256];
            asm volatile("" ::: "memory"); } }
    __syncthreads();
    for (int c = 0; c < 4; ++c) {
        const float u_prev = (c == 0) ? -m_start : sU[64 * c - 1]; const float u_last = sU[64 * c + 63];
        const size_t row0 = (size_t)b * SEQ + j * 256 + c * 64;
        { const int s = tid & 63, dg = tid >> 6, tokl = 64 * c + s, tseq = j * 256 + tokl; const float wst = __expf(sA[tokl] + u_last) * KSCALE;
#pragma unroll
            for (int q = 0; q < 2; ++q) { float kc[8]; conv8(QK, (size_t)b * SEQ, tseq, 512 + 128 * h + 16 * dg + 8 * q, cwk, 16 * dg + 8 * q, kc);
                *(LAS u32x4*)(Kc + s * 136 + 16 * dg + 8 * q) = pack8(kc);
#pragma unroll
                for (int e = 0; e < 8; ++e) KWT[(16 * dg + 8 * q + e) * 72 + s] = bf1(kc[e] * wst); asm volatile("" ::: "memory"); } }
#pragma unroll
        for (int i = 0; i < 2; ++i) { const int idq = tid + 512 * i, t = idq >> 4, chq = idq & 15; float qc[8];
            conv8(QK, (size_t)b * SEQ, j * 256 + 64 * c + t, 128 * h + 8 * chq, cwq, 8 * chq, qc); *(LAS u32x4*)(Qc + t * 136 + 8 * chq) = pack8(qc); asm volatile("" ::: "memory"); }
        stage_vt(MV, row0, h, VT, tid);
        if (tid < 64) sInter[tid] = __expf(sU[64 * c + tid] - u_prev);
        __syncthreads();
        if (wid < 4) {
            const int si = wid >> 1, ti = wid & 1; f32x16 st;
#pragma unroll
            for (int e = 0; e < 16; ++e) st[e] = 0.f;
#pragma unroll
            for (int ks = 0; ks < 8; ++ks) { const bf16x8 a = *(const LAS bf16x8*)(Kc + (si * 32 + r) * 136 + 16 * ks + 8 * hh); const bf16x8 bq = *(const LAS bf16x8*)(Qc + (ti * 32 + r) * 136 + 16 * ks + 8 * hh);
                st = MFMA32(a, bq, st); }
            const int t = ti * 32 + r; const float ut = sU[64 * c + t]; float rs = 0.f;
#pragma unroll
            for (int g = 0; g < 4; ++g) { float w4[4];
#pragma unroll
                for (int i = 0; i < 4; ++i) { const int sl = si * 32 + 8 * g + 4 * hh + i; const float wv = (sl <= t) ? __expf(sA[64 * c + sl] + ut) * st[4 * g + i] * KSCALE : 0.f; rs += wv; w4[i] = wv; }
                *(LAS u32x2*)(W + t * 72 + si * 32 + 8 * g + 4 * hh) = (u32x2){cvt_pk_bf16(w4[0], w4[1]), cvt_pk_bf16(w4[2], w4[3])}; }
            sRS[(si * 2 + hh) * 64 + t] = rs;
        } else {
            const int tq = (tid - 256) >> 2, part = tid & 3; float v = 0.f;
#pragma unroll
            for (int q = 0; q < 4; ++q) { float x[8]; unpack8(*(const LAS u32x4*)(Qc + tq * 136 + 32 * part + 8 * q), x);
#pragma unroll
                for (int e = 0; e < 8; ++e) v += x[e] * sN[32 * part + 8 * q + e]; }
            v += __shfl_xor(v, 1); v += __shfl_xor(v, 2);
            if (part == 0) sQN[tq] = v;
        }
        __syncthreads();
        if (tid < 64) { const float den = (sRS[tid] + sRS[64 + tid]) + (sRS[128 + tid] + sRS[192 + tid]) + sInter[tid] * sQN[tid];
            sRden[tid] = 1.f / fmaxf(fabsf(den), __expf(sU[64 * c + tid] - sG[64 * c + tid])); }
        f32x16 Y[2];
#pragma unroll
        for (int i = 0; i < 2; ++i)
#pragma unroll
            for (int e = 0; e < 16; ++e) Y[i][e] = 0.f;
#pragma unroll
        for (int dt = 0; dt < 4; ++dt)
#pragma unroll
            for (int s2 = 0; s2 < 2; ++s2) { u32x4 cw;
                cw.x = cvt_pk_bf16(Cacc[dt][8 * s2 + 0], Cacc[dt][8 * s2 + 1]); cw.y = cvt_pk_bf16(Cacc[dt][8 * s2 + 2], Cacc[dt][8 * s2 + 3]);
                cw.z = cvt_pk_bf16(Cacc[dt][8 * s2 + 4], Cacc[dt][8 * s2 + 5]); cw.w = cvt_pk_bf16(Cacc[dt][8 * s2 + 6], Cacc[dt][8 * s2 + 7]);
                const bf16x8 bc = __builtin_bit_cast(bf16x8, cw);
#pragma unroll
                for (int i = 0; i < 2; ++i) { const LAS bf16_t* qp = Qc + (i * 32 + r) * 136 + dt * 32 + 16 * s2 + 4 * hh;
                    const u32x2 lo = *(const LAS u32x2*)qp, hi = *(const LAS u32x2*)(qp + 8); const u32x4 qa = (u32x4){lo.x, lo.y, hi.x, hi.y};
                    Y[i] = MFMA32(__builtin_bit_cast(bf16x8, qa), bc, Y[i]); } }
#pragma unroll
        for (int i = 0; i < 2; ++i)
#pragma unroll
            for (int e = 0; e < 16; ++e) Y[i][e] *= sInter[i * 32 + crow(e, hh)];
        bf16x8 bv[4];
#pragma unroll
        for (int ks = 0; ks < 4; ++ks) bv[ks] = *(const LAS bf16x8*)(VT + (32 * wid + r) * 72 + 16 * ks + 8 * hh);
#pragma unroll
        for (int ks = 0; ks < 4; ++ks)
#pragma unroll
            for (int i = 0; i < 2; ++i) { const bf16x8 a = *(const LAS bf16x8*)(W + (i * 32 + r) * 72 + 16 * ks + 8 * hh); Y[i] = MFMA32(a, bv[ks], Y[i]); }
        if (c < 3) {
            const float decay = sInter[63];
#pragma unroll
            for (int dt = 0; dt < 4; ++dt) {
#pragma unroll
                for (int e = 0; e < 16; ++e) Cacc[dt][e] *= decay;
#pragma unroll
                for (int ks = 0; ks < 4; ++ks) { const bf16x8 a = *(const LAS bf16x8*)(KWT + (dt * 32 + r) * 72 + 16 * ks + 8 * hh); Cacc[dt] = MFMA32(a, bv[ks], Cacc[dt]); } }
            if (tid < 128) { float sn = 0.f;
#pragma unroll
                for (int q = 0; q < 8; ++q) { float x[8]; unpack8(*(const LAS u32x4*)(KWT + tid * 72 + 8 * q), x);
#pragma unroll
                    for (int e = 0; e < 8; ++e) sn += x[e]; }
                sN[tid] = decay * sN[tid] + sn; }
        }
        __syncthreads();
#pragma unroll
        for (int i = 0; i < 2; ++i)
#pragma unroll
            for (int e = 0; e < 16; ++e) { const int t = i * 32 + crow(e, hh); H[t * 260 + 32 * wid + r] = Y[i][e] * sRden[t]; }
        __syncthreads();
        { const int t = tid >> 3, cgp = tid & 7; f32x4 hv[8]; float ss = 0.f;
#pragma unroll
            for (int q = 0; q < 8; ++q) { hv[q] = *(const LAS f32x4*)(H + t * 260 + 32 * cgp + 4 * q); ss += (hv[q].x * hv[q].x + hv[q].y * hv[q].y) + (hv[q].z * hv[q].z + hv[q].w * hv[q].w); }
            ss += __shfl_xor(ss, 1); ss += __shfl_xor(ss, 2); ss += __shfl_xor(ss, 4);
            const float rinv = rsqrtf(ss * (1.f / 256.f) + RMS_EPS);
            const size_t ro = (row0 + t) * 1024 + h * 256 + 32 * cgp; const float* mng = inptr(IN_MNG) + h * 256 + 32 * cgp;
#pragma unroll
            for (int q = 0; q < 4; ++q) { float mo[8], gm[8], ga[8], ya[8], o[8];
                unpack8(*(const u32x4*)(MO + ro + 8 * q), mo); unpack8(*(const u32x4*)(GM + ro + 8 * q), gm); unpack8(*(const u32x4*)(GA + ro + 8 * q), ga); unpack8(*(const u32x4*)(YA + ro + 8 * q), ya);
                const f32x4 g0 = *(const f32x4*)(mng + 8 * q), g1 = *(const f32x4*)(mng + 8 * q + 4);
#pragma unroll
                for (int e = 0; e < 8; ++e) { const float hval = (e < 4 ? hv[2 * q][e & 3] : hv[2 * q + 1][e & 3]) * rinv; const float gg = e < 4 ? g0[e & 3] : g1[e & 3];
                    const float ym = sigmoidf_(mo[e]) * hval * gg; o[e] = sigmoidf_(gm[e]) * ym + sigmoidf_(ga[e]) * ya[e]; }
                *(u32x4*)(GM + ro + 8 * q) = pack8(o); asm volatile("" ::: "memory"); } }
        __syncthreads();
    }
}

DI void smlstm_item(Frame& F, int it) {
    const int b = it >> 2, h = it & 3, tid = F.tid, lane = F.lane, wid = F.wave;
    LAS float* sq = (LAS float*)(F.lds + 0); LAS float* sk = (LAS float*)(F.lds + 512); LAS float* sv = (LAS float*)(F.lds + 1024);
    LAS float* sred = (LAS float*)(F.lds + 2048);
    LAS float* part = (LAS float*)(F.lds + 4096);
    const size_t row = (size_t)NP + b;
    const bf16_t* QK = (const bf16_t*)(F.ws + WS_QK); const bf16_t* MV = (const bf16_t*)(F.ws + WS_MV); const float* GT = (const float*)(F.ws + WS_GT);
    const bf16_t* MO = (const bf16_t*)(F.ws + WS_MO); const bf16_t* YA = (const bf16_t*)(F.ws + WS_AQ); bf16_t* GM = (bf16_t*)(F.ws + WS_GM); const bf16_t* GA = (const bf16_t*)(F.ws + WS_GA);
    const float* n0 = inptr(IN_N0) + (size_t)(b * 4 + h) * 128;
    if (tid < 256) { const int c = tid < 128 ? 128 * h + tid : 512 + 128 * h + (tid - 128);
        const float x = bflo((unsigned)QK[row * 1024 + c]); const float* sc = inptr(IN_CONV0) + (size_t)b * 3072 + c; const float* cw = inptr(IN_CW) + c;
        const float y = cw[0] * sc[0] + cw[1024] * sc[1024] + cw[2048] * sc[2048] + cw[3072] * x + inptr(IN_CB)[c];
        const float val = siluf_(y);
        if (tid < 128) sq[tid] = val; else sk[tid - 128] = val * KSCALE;
        float* cs = F.out + O_CONVS + (size_t)b * 3072 + c; cs[0] = sc[1024]; cs[1024] = sc[2048]; cs[2048] = x;
    } else sv[tid - 256] = bflo((unsigned)MV[row * 1024 + h * 256 + (tid - 256)]);
    __syncthreads();
    if (wid == 0) { float a = sq[lane] * sk[lane] + sq[lane + 64] * sk[lane + 64]; float bq = sq[lane] * n0[lane] + sq[lane + 64] * n0[lane + 64];
        a = wave_sum(a); bq = wave_sum(bq); if (lane == 0) { sred[0] = a; sred[1] = bq; } }
    __syncthreads();
    const float qk = sred[0], qn = sred[1];
    const float ipre = GT[row * 8 + h], fpre = GT[row * 8 + 4 + h];
    const float logf = fminf(fpre, 0.f) - log1pf(expf(-fabsf(fpre)));
    const float m0 = inptr(IN_M0)[b * 4 + h]; const float m_inter = logf + m0, m_t = fmaxf(m_inter, ipre);
    const float wgt = expf(ipre - m_t), inter = expf(m_inter - m_t);
    { const int pt = tid >> 6, vq = tid & 63; const float* C0 = inptr(IN_C0) + (size_t)(b * 4 + h) * 32768; float* Cs = F.out + O_CS + (size_t)(b * 4 + h) * 32768;
        const f32x4 v4 = *(const LAS f32x4*)(sv + 4 * vq); f32x4 a4 = (f32x4){0.f, 0.f, 0.f, 0.f};
#pragma unroll 4
        for (int dd = 0; dd < 16; ++dd) { const int d = 16 * pt + dd; const f32x4 c4 = *(const f32x4*)(C0 + (size_t)d * 256 + 4 * vq); a4 = a4 + c4 * sq[d];
            *(f32x4*)(Cs + (size_t)d * 256 + 4 * vq) = c4 * inter + v4 * (wgt * sk[d]); }
        *(LAS f32x4*)(part + pt * 256 + 4 * vq) = a4; }
    if (tid < 128) F.out[O_NS + (size_t)(b * 4 + h) * 128 + tid] = inter * n0[tid] + wgt * sk[tid];
    if (tid == 0) F.out[O_MS + b * 4 + h] = m_t;
    __syncthreads();
    float hv = 0.f;
    if (tid < 256) { float qC = 0.f;
#pragma unroll
        for (int p = 0; p < 8; ++p) qC += part[p * 256 + tid];
        const float num = wgt * qk * sv[tid] + inter * qC; const float den = wgt * qk + inter * qn;
        hv = num / fmaxf(fabsf(den), expf(-m_t));
        const float ss = wave_sum(hv * hv); if (lane == 0) sred[8 + wid] = ss; }
    __syncthreads();
    if (tid < 256) { const float ss = (sred[8] + sred[9]) + (sred[10] + sred[11]); const float rinv = rsqrtf(ss * (1.f / 256.f) + RMS_EPS);
        const int col = h * 256 + tid; const size_t ro = row * 1024 + col;
        const float ym = sigmoidf_(bflo((unsigned)MO[ro])) * hv * rinv * inptr(IN_MNG)[col];
        const float o = sigmoidf_(bflo((unsigned)GM[ro])) * ym + sigmoidf_(bflo((unsigned)GA[ro])) * bflo((unsigned)YA[ro]);
        GM[ro] = bf1(o); }
    __syncthreads();
}

DI void ln1_rows(Frame& F) {
    const int gw = F.bid * 8 + F.wave, NGW = F.G * 8, lane = F.lane;
    const float* U1 = (const float*)(F.ws + WS_U1); bf16_t* X1 = (bf16_t*)(F.ws + WS_X1); bf16_t* PB = (bf16_t*)(F.ws + WS_PB);
    f32x4 g4[4], b4[4];
#pragma unroll
    for (int j = 0; j < 4; ++j) { g4[j] = *(const f32x4*)(inptr(IN_LN1G) + 4 * lane + 256 * j); b4[j] = *(const f32x4*)(inptr(IN_LN1B) + 4 * lane + 256 * j); }
    for (int m = gw; m < MP; m += NGW) {
        unsigned long long* o8 = (unsigned long long*)(X1 + (size_t)m * 1024) + lane; unsigned long long* p8 = (unsigned long long*)(PB + (size_t)m * 256) + lane;
        if (m >= NTOK) {
#pragma unroll
            for (int j = 0; j < 4; ++j) o8[64 * j] = 0ull;
            *p8 = 0ull; continue; }
        const float* src = U1 + (size_t)m * 1024;
        f32x4 v[4]; float s = 0.f;
#pragma unroll
        for (int j = 0; j < 4; ++j) { v[j] = *(const f32x4*)(src + 4 * lane + 256 * j); s += (v[j].x + v[j].y) + (v[j].z + v[j].w); }
        const float mean = wave_sum(s) * (1.f / 1024.f); float s2 = 0.f;
#pragma unroll
        for (int j = 0; j < 4; ++j) { v[j] = v[j] - mean; s2 += (v[j].x * v[j].x + v[j].y * v[j].y) + (v[j].z * v[j].z + v[j].w * v[j].w); }
        const float rstd = 1.f / sqrtf(wave_sum(s2) * (1.f / 1024.f) + LN_EPS);
#pragma unroll
        for (int j = 0; j < 4; ++j) { v[j] = v[j] * rstd * g4[j] + b4[j];
            o8[64 * j] = (unsigned long long)cvt_pk_bf16(v[j].x, v[j].y) | ((unsigned long long)cvt_pk_bf16(v[j].z, v[j].w) << 32); }
        const float* ps = m < NP ? inptr(IN_PP) + (size_t)m * 256 : inptr(IN_PS) + (size_t)(m - NP) * 256;
        const f32x4 pv = *(const f32x4*)(ps + 4 * lane);
        *p8 = (unsigned long long)cvt_pk_bf16(pv.x, pv.y) | ((unsigned long long)cvt_pk_bf16(pv.z, pv.w) << 32);
    }
}
DI void ln2_rows(Frame& F) {
    const int gw = F.bid * 8 + F.wave, NGW = F.G * 8, lane = F.lane;
    f32x4 g4[4], b4[4];
#pragma unroll
    for (int j = 0; j < 4; ++j) { g4[j] = *(const f32x4*)(inptr(IN_LN2G) + 4 * lane + 256 * j); b4[j] = *(const f32x4*)(inptr(IN_LN2B) + 4 * lane + 256 * j); }
    for (int m = gw; m < NTOK; m += NGW) {
        float* src = F.out + O_Y + (size_t)m * 1024;
        f32x4 v[4]; float s = 0.f;
#pragma unroll
        for (int j = 0; j < 4; ++j) { v[j] = *(const f32x4*)(src + 4 * lane + 256 * j); s += (v[j].x + v[j].y) + (v[j].z + v[j].w); }
        const float mean = wave_sum(s) * (1.f / 1024.f); float s2 = 0.f;
#pragma unroll
        for (int j = 0; j < 4; ++j) { v[j] = v[j] - mean; s2 += (v[j].x * v[j].x + v[j].y * v[j].y) + (v[j].z * v[j].z + v[j].w * v[j].w); }
        const float rstd = 1.f / sqrtf(wave_sum(s2) * (1.f / 1024.f) + LN_EPS);
#pragma unroll
        for (int j = 0; j < 4; ++j) *(f32x4*)(src + 4 * lane + 256 * j) = v[j] * rstd * g4[j] + b4[j];
    }
}
DI void p2_copies(Frame& F) {
    const int gt = F.bid * 512 + F.tid, NT = F.G * 512;
    const bf16_t* QK = (const bf16_t*)(F.ws + WS_QK); const bf16_t* AKV = (const bf16_t*)(F.ws + WS_AKV);
    for (int idx = gt; idx < 8 * 3 * 1024; idx += NT) { const int b = idx / 3072, rem = idx % 3072, i = rem >> 10, c = rem & 1023;
        F.out[O_CONVP + idx] = bflo((unsigned)QK[((size_t)b * SEQ + SEQ - 3 + i) * 1024 + c]); }
    for (int idx = gt; idx < 8 * 128 * 128; idx += NT) { const int b = idx >> 14, kk = (idx >> 7) & 127, c = idx & 127; const size_t rw = ((size_t)b * SEQ + SEQ - 128 + kk) * 256;
        F.out[O_KP + idx] = bflo((unsigned)AKV[rw + c]); F.out[O_VP + idx] = bflo((unsigned)AKV[rw + 128 + c]); }
}

__global__ void __launch_bounds__(512, 2) fwd_megakernel(Args args) {
    extern __shared__ __attribute__((aligned(16))) unsigned char lds_raw[];
    cg::grid_group grid = cg::this_grid();
    Frame F;
    F.lds = (LAS unsigned char*)lds_raw; F.tid = threadIdx.x; F.lane = F.tid & 63; F.wave = __builtin_amdgcn_readfirstlane(F.tid >> 6); F.G = gridDim.x; F.bid = blockIdx.x;
    F.out = args.out; F.ws = args.ws;
    unsigned char* ws = F.ws;
    p0_prologue(F);
    grid.sync();
    { pg8::Gemm g{(const bf16_t*)(ws + WS_XN), (const bf16_t*)(ws + WS_WIN), MP, NZ, 1024}; pg8::StaticOrder S; S.init(MP, NZ, F.G, F.bid);
      epi::EpiZ E{ws}; pg8::gemm_phase<epi::EpiZ, pg8::StaticOrder, true, true>(F.lds, g, S, E); }
    grid.sync();
    for (int it = F.bid; it < 512; it += F.G) mlstm_a_item(F, it);
    for (int it = F.bid; it < 1024; it += F.G) attn_unit(F, it);
    for (int it = F.bid; it < 128; it += F.G) sattn_item(F, it);
    p2_copies(F);
    grid.sync();
    for (int it = F.bid; it < 256; it += F.G) scan_item(F, it);
    grid.sync();
    for (int it = F.bid; it < 512; it += F.G) mlstm_c_item(F, it);
    for (int it = F.bid; it < 512; it += F.G) smlstm_item(F, it);
    grid.sync();
    { pg8::Gemm g{(const bf16_t*)(ws + WS_GM), (const bf16_t*)(ws + WS_WOUT), MP, 1024, 1024}; pg8::StaticOrder S; S.init(MP, 1024, F.G, F.bid);
      epi::EpiU1 E{(const bf16_t*)(ws + WS_XN), (float*)(ws + WS_U1)}; pg8::gemm_phase<epi::EpiU1, pg8::StaticOrder, true, true>(F.lds, g, S, E); }
    grid.sync();
    ln1_rows(F);
    grid.sync();
    { pg8::Gemm g{(const bf16_t*)(ws + WS_X1), (const bf16_t*)(ws + WS_WGU), MP, 2 * DFF, 1024}; pg8::StaticOrder S; S.init(MP, 2 * DFF, F.G, F.bid);
      epi::EpiGU E{(bf16_t*)(ws + WS_ACT)}; pg8::gemm_phase<epi::EpiGU, pg8::StaticOrder, true, true>(F.lds, g, S, E); }
    { int kpd = PD; asm volatile("" : "+s"(kpd)); pg8::Gemm g{(const bf16_t*)(ws + WS_PB), (const bf16_t*)(ws + WS_WPLE), MP, 1024, kpd}; pg8::StaticOrder S; S.init(MP, 1024, F.G, F.bid);
      epi::EpiT1 E{(bf16_t*)(ws + WS_T1)}; pg8::gemm_phase<epi::EpiT1, pg8::StaticOrder, true, true>(F.lds, g, S, E); }
    { pg8::Gemm g{(const bf16_t*)(ws + WS_X1), (const bf16_t*)(ws + WS_WPG), MP, 1024, 1024}; pg8::StaticOrder S; S.init(MP, 1024, F.G, F.bid);
      epi::EpiPLE E{(const bf16_t*)(ws + WS_T1), (bf16_t*)(ws + WS_PLE)}; pg8::gemm_phase<epi::EpiPLE, pg8::StaticOrder, true, true>(F.lds, g, S, E); }
    grid.sync();
    { pg8::Gemm g{(const bf16_t*)(ws + WS_ACT), (const bf16_t*)(ws + WS_WDN), MP, 1024, DFF}; pg8::StaticOrder S; S.init(MP, 1024, F.G, F.bid);
      epi::EpiDN E{(const bf16_t*)(ws + WS_X1), (const bf16_t*)(ws + WS_PLE), F.out + O_Y}; pg8::gemm_phase<epi::EpiDN, pg8::StaticOrder, true, true>(F.lds, g, S, E); }
    grid.sync();
    ln2_rows(F);
}

extern "C" void kernel_launch(void* const* d_in, const int* in_sizes, int n_in, void* d_out, int out_size, void* d_ws, size_t ws_size, hipStream_t stream) {
    static int grid = 0;
    if (grid == 0) {
        if (n_in != 28 || (size_t)out_size != O_END || ws_size < WS_END) { fprintf(stderr, "kernel_launch: shape mismatch n_in %d out %d (want %zu) ws %zu (want %zu)\n", n_in, out_size, (size_t)O_END, ws_size, (size_t)WS_END); grid = -1; return; }
        int dev = 0, cus = 0, per_cu = 0;
        hipGetDevice(&dev); hipDeviceGetAttribute(&cus, hipDeviceAttributeMultiprocessorCount, dev);
        hipFuncSetAttribute((const void*)fwd_megakernel, hipFuncAttributeMaxDynamicSharedMemorySize, LDS_BYTES);
        hipOccupancyMaxActiveBlocksPerMultiprocessor(&per_cu, (const void*)fwd_megakernel, 512, LDS_BYTES);
        if (per_cu < 1) per_cu = 1;
        grid = cus * per_cu;
        (void)hipGetLastError();
    }
    if (grid < 0) return;
    Args a{};
    for (int i = 0; i < 28; ++i) a.in[i] = (const float*)d_in[i];
    a.out = (float*)d_out; a.ws = (unsigned char*)d_ws;
    void* kargs[] = {&a};
    hipError_t e = hipLaunchCooperativeKernel((const void*)fwd_megakernel, dim3(grid), dim3(512), kargs, LDS_BYTES, stream);
    if (e != hipSuccess) fprintf(stderr, "cooperative launch failed: %s (grid %d)\n", hipGetErrorString(e), grid);
}
```

```cpp
#include <hip/hip_runtime.h>
#include <hip/hip_cooperative_groups.h>
#include <cstdio>
#include <cstdint>
namespace cg = cooperative_groups;
namespace pg8 {
#define PG8_LAS __attribute__((address_space(3)))
typedef unsigned short bf16_t;
typedef short bf16x8 __attribute__((ext_vector_type(8)));
typedef float f32x4 __attribute__((ext_vector_type(4)));
typedef unsigned u32x4 __attribute__((ext_vector_type(4)));
constexpr int BM = 256, BK = 64, HALF = 128, HTB = HALF * BK * 2  , STAGE_BYTES = 8 * HTB, NXCD = 8, WGM = 8;

__host__ __device__ __forceinline__ int lds_byte(int r, int c) { const int st = (r >> 4) * 2 + (c >> 5), rr = r & 15, cc = c & 31, ob = rr * 64 + cc * 2; return st * 1024 + (ob ^ (((ob >> 9) & 1) << 5)); }
__host__ __device__ __forceinline__ void stage_rc(int b, int& R, int& C) { const int st = b / 1024, sb = b % 1024, swz = sb ^ (((sb >> 9) & 1) << 5); R = (st >> 1) * 16 + swz / 64; C = (st & 1) * 32 + (swz % 64) / 2; }
__host__ __device__ __forceinline__ int perm32(int rho) { const int n = rho >> 4, i = rho & 15; return 8 * (i >> 2) + 4 * n + (i & 3); }

struct Unit { int pm, pn; };
struct Gemm { const bf16_t* A; const bf16_t* Bt; int M, N, K; };

struct StaticOrder {
    int nM, nN, nwg, G, c;
    __host__ __device__ void init(int M, int N, int G_, int c_) { nM = M / BM; nN = N / BM; nwg = nM * nN; G = G_; c = c_; }
    __host__ __device__ bool next(int i, Unit& u) const {
        const long L = (long)i * G + c; if (L >= nwg) return false;
        int wgid = (int)L; { const int q = nwg / NXCD, r = nwg % NXCD, xcd = wgid % NXCD, off = wgid / NXCD; wgid = (xcd < r ? xcd * (q + 1) : r * (q + 1) + (xcd - r) * q) + off; }
        const int nig = WGM * nN, gid = wgid / nig, fm = gid * WGM, gsz = (nM - fm) < WGM ? (nM - fm) : WGM;
        u.pm = fm + ((wgid % nig) % gsz); u.pn = (wgid % nig) / gsz; return true;
    }
    __device__ __forceinline__ void a_ready(const Unit&) const {}
    __device__ __forceinline__ void done(const Unit&) const {}
};

__device__ __forceinline__ unsigned cvt_pk_bf16(float lo, float hi) { typedef float f2 __attribute__((ext_vector_type(2))); typedef __bf16 b2 __attribute__((ext_vector_type(2))); f2 v = {lo, hi}; b2 b = __builtin_convertvector(v, b2); return __builtin_bit_cast(unsigned, b); }
__device__ __forceinline__ float bflo(unsigned w) { return __uint_as_float(w << 16); }
__device__ __forceinline__ float bfhi(unsigned w) { return __uint_as_float(w & 0xffff0000u); }
template <class Epi, class Sched, bool ALIGN_EPI = false, bool SP2 = false>
__device__ __forceinline__ void gemm_phase(PG8_LAS unsigned char* lds, const Gemm g, const Sched& S, const Epi& E) {
    int tid_ = threadIdx.x; asm volatile("" : "+v"(tid_));
    const int tid = tid_, wid = __builtin_amdgcn_readfirstlane(tid >> 6), lane = tid & 63, wr = wid >> 2, wc = wid & 3, fr = lane & 15, fq = lane >> 4;
    const int K = g.K, nt = K / BK;
    unsigned voffA[2], voffB[2];
#pragma unroll
    for (int i = 0; i < 2; ++i) { int R, C; stage_rc(tid * 16 + i * 8192, R, C); const int Rb = Epi::PERM ? ((R & ~31) + perm32(R & 31)) : R;
        voffA[i] = (unsigned)(R * K + C) * 2u; voffB[i] = (unsigned)(Rb * K + C) * 2u; }
    const size_t kstep = (size_t)(BK * 2);
    const size_t hstep = (size_t)HALF * K * 2;
    const size_t tstep = 2 * hstep;
    const unsigned ldsw = (unsigned)wid * 1024u;
    const int aoff = lds_byte(wr * 64 + fr, fq * 8), boff = lds_byte(wc * 32 + fr, fq * 8);
#define PG8_SA(b, h) (((b) * 2 + (h)) * HTB)
#define PG8_SB(b, h) ((4 + (b) * 2 + (h)) * HTB)
#define PG8_STAGE(bufoff, gbase, voff) do { _Pragma("unroll") for (int _i = 0; _i < 2; ++_i) \
        __builtin_amdgcn_global_load_lds((const unsigned*)((const char*)(gbase) + (voff)[_i]), (PG8_LAS unsigned*)(lds + (bufoff) + ldsw + _i * 8192), 16, 0, 0); } while (0)
#define PG8_LDA(dst, b, h) do { _Pragma("unroll") for (int m = 0; m < 4; ++m) _Pragma("unroll") for (int k = 0; k < 2; ++k) dst[m][k] = *(const PG8_LAS bf16x8*)(lds + PG8_SA(b, h) + aoff + m * 2048 + k * 1024); } while (0)
#define PG8_LDB(dst, b, h) do { _Pragma("unroll") for (int n = 0; n < 2; ++n) _Pragma("unroll") for (int k = 0; k < 2; ++k) dst[n][k] = *(const PG8_LAS bf16x8*)(lds + PG8_SB(b, h) + boff + n * 2048 + k * 1024); } while (0)
#define PG8_MMA(ai, bj, At, Bt) do { __builtin_amdgcn_s_setprio(1); _Pragma("unroll") for (int m = 0; m < 4; ++m) _Pragma("unroll") for (int n = 0; n < 2; ++n) _Pragma("unroll") for (int k = 0; k < 2; ++k) \
        acc[ai][bj][m][n] = __builtin_amdgcn_mfma_f32_16x16x32_bf16(Bt[n][k], At[m][k], acc[ai][bj][m][n], 0, 0, 0); __builtin_amdgcn_s_setprio(0); } while (0)
#define PG8_WAIT_V(n) asm volatile("s_waitcnt vmcnt(" #n ")" ::: "memory")
#define PG8_WAIT_L(n) asm volatile("s_waitcnt lgkmcnt(" #n ")" ::: "memory")
#define PG8_BAR __builtin_amdgcn_s_barrier()
#define PG8_SCHED __builtin_amdgcn_sched_barrier(0)
    Unit cur, nxt; int ui = 0;
    if (!S.next(0, cur)) return;
    f32x4 acc[2][2][4][2];
#pragma unroll
    for (int a = 0; a < 2; ++a)
#pragma unroll
        for (int b = 0; b < 2; ++b)
#pragma unroll
            for (int m = 0; m < 4; ++m)
#pragma unroll
                for (int n = 0; n < 2; ++n) acc[a][b][m][n] = (f32x4){0.f, 0.f, 0.f, 0.f};
    bf16x8 At[4][2], B0[2][2], B1[2][2];
    const char* cA = (const char*)g.A + (size_t)cur.pm * tstep; const char* cB = (const char*)g.Bt + (size_t)cur.pn * tstep;
    S.a_ready(cur);
    if constexpr (SP2) {
        PG8_STAGE(PG8_SB(0, 0), cB, voffB); PG8_STAGE(PG8_SB(0, 1), cB + hstep, voffB); PG8_STAGE(PG8_SA(0, 0), cA, voffA); PG8_STAGE(PG8_SA(0, 1), cA + hstep, voffA);
        if (wr == 1) PG8_BAR;
        PG8_WAIT_V(2); PG8_BAR;
        PG8_STAGE(PG8_SB(1, 0), cB + kstep, voffB); PG8_STAGE(PG8_SA(1, 0), cA + kstep, voffA); PG8_STAGE(PG8_SB(1, 1), cB + hstep + kstep, voffB);
        PG8_WAIT_V(6); PG8_BAR;
    } else {
        PG8_STAGE(PG8_SB(0, 0), cB, voffB); PG8_STAGE(PG8_SA(0, 0), cA, voffA); PG8_STAGE(PG8_SB(0, 1), cB + hstep, voffB); PG8_STAGE(PG8_SA(0, 1), cA + hstep, voffA);
        if (wr == 1) PG8_BAR;
        PG8_WAIT_V(4); PG8_BAR;
        PG8_STAGE(PG8_SB(1, 0), cB + kstep, voffB); PG8_STAGE(PG8_SA(1, 0), cA + kstep, voffA); PG8_STAGE(PG8_SB(1, 1), cB + hstep + kstep, voffB);
        PG8_WAIT_V(6); PG8_BAR;
    }
    for (;;) {
        const bool has_next = S.next(ui + 1, nxt);
        const char* nA = has_next ? (const char*)g.A + (size_t)nxt.pm * tstep : cA; const char* nB = has_next ? (const char*)g.Bt + (size_t)nxt.pn * tstep : cB;
        for (int t = 0; t < nt; t += 2) {
            const bool last = (t == nt - 2);
            const char* a1 = cA + (size_t)(t + 1) * kstep;
            const char* a2 = last ? nA : cA + (size_t)(t + 2) * kstep; const char* b2 = last ? nB : cB + (size_t)(t + 2) * kstep;
            const char* a3 = a2 + kstep; const char* b3 = b2 + kstep;
            if (last && has_next) S.a_ready(nxt);
            if constexpr (SP2) {
            PG8_LDB(B0, 0, 0); PG8_LDB(B1, 0, 1); PG8_SCHED; PG8_LDA(At, 0, 0); PG8_STAGE(PG8_SA(1, 1), a1 + hstep, voffA);
            PG8_WAIT_V(8); PG8_WAIT_L(0); PG8_BAR; PG8_MMA(0, 0, At, B0); PG8_MMA(0, 1, At, B1); PG8_BAR; PG8_SCHED;
            PG8_LDA(At, 0, 1); PG8_STAGE(PG8_SB(0, 0), b2, voffB); PG8_STAGE(PG8_SB(0, 1), b2 + hstep, voffB); PG8_STAGE(PG8_SA(0, 0), a2, voffA);
            PG8_WAIT_V(8); PG8_WAIT_L(0); PG8_BAR; PG8_MMA(1, 0, At, B0); PG8_MMA(1, 1, At, B1); PG8_BAR; PG8_SCHED;
            PG8_LDB(B0, 1, 0); PG8_LDB(B1, 1, 1); PG8_SCHED; PG8_LDA(At, 1, 0); PG8_STAGE(PG8_SA(0, 1), a2 + hstep, voffA);
            PG8_WAIT_V(8); PG8_WAIT_L(0); PG8_BAR; PG8_MMA(0, 0, At, B0); PG8_MMA(0, 1, At, B1); PG8_BAR; PG8_SCHED;
            PG8_LDA(At, 1, 1); PG8_STAGE(PG8_SB(1, 0), b3, voffB); PG8_STAGE(PG8_SB(1, 1), b3 + hstep, voffB); PG8_STAGE(PG8_SA(1, 0), a3, voffA);
            PG8_WAIT_V(8); PG8_WAIT_L(0); PG8_BAR; PG8_MMA(1, 0, At, B0); PG8_MMA(1, 1, At, B1); PG8_BAR; PG8_SCHED;
            } else {
            PG8_LDB(B0, 0, 0); PG8_SCHED; PG8_LDA(At, 0, 0); PG8_STAGE(PG8_SA(1, 1), a1 + hstep, voffA);
            PG8_WAIT_L(8); PG8_BAR; PG8_WAIT_L(0); PG8_MMA(0, 0, At, B0); PG8_BAR; PG8_SCHED;
            PG8_LDB(B1, 0, 1); PG8_STAGE(PG8_SB(0, 0), b2, voffB);
            PG8_BAR; PG8_WAIT_L(0); PG8_MMA(0, 1, At, B1); PG8_BAR;
            PG8_LDA(At, 0, 1); PG8_STAGE(PG8_SA(0, 0), a2, voffA);
            PG8_BAR; PG8_WAIT_L(0); PG8_MMA(1, 0, At, B0); PG8_BAR; PG8_SCHED;
            PG8_STAGE(PG8_SB(0, 1), b2 + hstep, voffB);
            PG8_WAIT_V(6); PG8_BAR; PG8_MMA(1, 1, At, B1); PG8_BAR;
            PG8_LDB(B0, 1, 0); PG8_SCHED; PG8_LDA(At, 1, 0); PG8_STAGE(PG8_SA(0, 1), a2 + hstep, voffA);
            PG8_WAIT_L(8); PG8_BAR; PG8_WAIT_L(0); PG8_MMA(0, 0, At, B0); PG8_BAR; PG8_SCHED;
            PG8_LDB(B1, 1, 1); PG8_STAGE(PG8_SB(1, 0), b3, voffB);
            PG8_BAR; PG8_WAIT_L(0); PG8_MMA(0, 1, At, B1); PG8_BAR;
            PG8_LDA(At, 1, 1); PG8_STAGE(PG8_SA(1, 0), a3, voffA);
            PG8_BAR; PG8_WAIT_L(0); PG8_MMA(1, 0, At, B0); PG8_BAR; PG8_SCHED;
            PG8_STAGE(PG8_SB(1, 1), b3 + hstep, voffB);
            PG8_WAIT_V(6); PG8_BAR; PG8_MMA(1, 1, At, B1); PG8_BAR;
            }
        }
        if constexpr (ALIGN_EPI) { if (wr == 0) PG8_BAR; }
        if constexpr (!Epi::AFTER_DRAIN) { E(acc, cur, wr, wc, fr, fq); S.done(cur); }
        if (!has_next) break;
#pragma unroll
        for (int a = 0; a < 2; ++a)
#pragma unroll
            for (int b = 0; b < 2; ++b)
#pragma unroll
                for (int m = 0; m < 4; ++m)
#pragma unroll
                    for (int n = 0; n < 2; ++n) acc[a][b][m][n] = (f32x4){0.f, 0.f, 0.f, 0.f};
        cur = nxt; cA = nA; cB = nB; ++ui;
        if constexpr (ALIGN_EPI) { if (wr == 1) PG8_BAR; }
    }
    PG8_WAIT_V(0);
    if constexpr (!ALIGN_EPI) { if (wr == 0) PG8_BAR; }
    PG8_BAR;
    if constexpr (Epi::AFTER_DRAIN) { E.fused(acc, cur, wr, wc, fr, fq, lds, wid, lane); S.done(cur); }
#undef PG8_SA
#undef PG8_SB
#undef PG8_STAGE
#undef PG8_LDA
#undef PG8_LDB
#undef PG8_MMA
#undef PG8_WAIT_V
#undef PG8_WAIT_L
#undef PG8_BAR
#undef PG8_SCHED
}
}

#define DI __device__ __forceinline__
#define LAS __attribute__((address_space(3)))
typedef unsigned short bf16_t;
typedef short bf16x8 __attribute__((ext_vector_type(8)));
typedef short s16x4 __attribute__((ext_vector_type(4)));
typedef float f32x4 __attribute__((ext_vector_type(4)));
typedef float f32x16 __attribute__((ext_vector_type(16)));
typedef unsigned u32x4 __attribute__((ext_vector_type(4)));
typedef unsigned u32x2 __attribute__((ext_vector_type(2)));
using pg8::cvt_pk_bf16; using pg8::bflo; using pg8::bfhi;
#define MFMA32(a, b, c) __builtin_amdgcn_mfma_f32_32x32x16_bf16((a), (b), (c), 0, 0, 0)

constexpr int DM = 1024, SEQ = 4096, NB = 8, NP = NB * SEQ, NS = 128, NTOK = NP + NS, MP = 33024;
constexpr int DFF = 2816, PD = 256, INW = 6408, NZ = 6400;
constexpr int NSC = 16;
constexpr float LN_EPS = 1e-5f, RMS_EPS = 1e-6f;
constexpr float ALPHA = 1.189207115002721f;
constexpr float LOG2E = 1.4426950408889634f;
constexpr float C2 = 0.125f * 1.4426950408889634f;
constexpr float KSCALE = 0.08838834764831845f;

constexpr size_t MiB = 1u << 20;
constexpr size_t RB = (size_t)MP * 1024 * 2;
constexpr size_t WS_WIN = 1 * MiB;
constexpr size_t WS_WOUT = WS_WIN + (size_t)NZ * 1024 * 2;
constexpr size_t WS_WGU = WS_WOUT + (size_t)1024 * 1024 * 2;
constexpr size_t WS_WDN = WS_WGU + (size_t)2 * DFF * 1024 * 2;
constexpr size_t WS_WPLE = WS_WDN + (size_t)1024 * DFF * 2;
constexpr size_t WS_WPG = WS_WPLE + (size_t)1024 * PD * 2;
constexpr size_t WS_WEND = WS_WPG + (size_t)1024 * 1024 * 2;
constexpr size_t WS_GT = 36 * MiB;
constexpr size_t WS_SM = 38 * MiB;
constexpr size_t SM_G = 0, SM_MLOC = 2048, SM_MST = 4096, SM_NST = 8192, SM_DN = SM_NST + 32 * 16 * 128 * 4;
constexpr size_t WS_XN = 40 * MiB;
constexpr size_t WS_QK = WS_XN + RB, WS_MV = WS_QK + RB, WS_MO = WS_MV + RB, WS_AQ = WS_MO + RB, WS_AKV = WS_AQ + RB;
constexpr size_t WS_GM = WS_AKV + RB / 4, WS_GA = WS_GM + RB, WS_END = WS_GA + RB;
constexpr size_t WS_U1 = WS_QK, WS_X1 = WS_MO, WS_ACT = WS_AQ, WS_PB = WS_AQ + 3 * RB, WS_T1 = WS_QK, WS_PLE = WS_XN;
static_assert(WS_WEND <= WS_GT && WS_GT + (size_t)MP * 32 <= WS_SM && WS_SM + SM_DN + 32 * 16 * 128 * 4 <= WS_XN, "ws map");
static_assert(WS_PB + RB / 4 == WS_END && WS_ACT + (size_t)MP * DFF * 2 <= WS_PB, "ws overlay map");
constexpr size_t O_Y = 0, O_CP = (size_t)NTOK * 1024, O_NP = O_CP + 8 * 4 * 128 * 256, O_MP = O_NP + 8 * 4 * 128, O_CONVP = O_MP + 32;
constexpr size_t O_KP = O_CONVP + 8 * 3 * 1024, O_VP = O_KP + 8 * 128 * 128, O_CS = O_VP + 8 * 128 * 128, O_NS = O_CS + (size_t)128 * 4 * 128 * 256;
constexpr size_t O_MS = O_NS + 128 * 4 * 128, O_CONVS = O_MS + 512, O_KS = O_CONVS + 128 * 3 * 1024, O_VS = O_KS + (size_t)128 * 128 * 128, O_END = O_VS + (size_t)128 * 128 * 128;
constexpr size_t O_DC = 0, O_CST = (size_t)32 * 16 * 32768;

constexpr int LDS_BYTES = 159744, LDS_MISC = 159232;
constexpr int CW_BAR = 4096;
#ifndef REP_G
#define REP_G 1
#endif
#ifndef REP_P2
#define REP_P2 1
#endif
#ifndef REP_P4
#define REP_P4 1
#endif
#ifndef REP_MISC
#define REP_MISC 1
#endif

DI int launder_v(int x) { asm volatile("" : "+v"(x)); return x; }
DI int crow(int reg, int h) { return (reg & 3) + 8 * (reg >> 2) + 4 * h; }
DI float wave_sum(float v) {
#pragma unroll
    for (int o = 1; o < 64; o <<= 1) v += __shfl_xor(v, o);
    return v;
}
DI float sigmoidf_(float x) { return __builtin_amdgcn_rcpf(1.f + __expf(-x)); }
DI float siluf_(float x) { return x * sigmoidf_(x); }
DI void unpack8(const u32x4 w, float (&x)[8]) { x[0] = bflo(w.x); x[1] = bfhi(w.x); x[2] = bflo(w.y); x[3] = bfhi(w.y); x[4] = bflo(w.z); x[5] = bfhi(w.z); x[6] = bflo(w.w); x[7] = bfhi(w.w); }
DI u32x4 pack8(const float (&x)[8]) { u32x4 w; w.x = cvt_pk_bf16(x[0], x[1]); w.y = cvt_pk_bf16(x[2], x[3]); w.z = cvt_pk_bf16(x[4], x[5]); w.w = cvt_pk_bf16(x[6], x[7]); return w; }
DI unsigned short bf1(float x) { return (unsigned short)(cvt_pk_bf16(x, 0.f) & 0xffffu); }
#define LDS_WAIT() asm volatile("s_waitcnt lgkmcnt(0)" ::: "memory")

namespace epi {
using pg8::Unit;
typedef pg8::f32x4 A4;
struct EpiZ {
    static constexpr bool PERM = true, AFTER_DRAIN = false;
    unsigned char* ws;
    DI void operator()(const A4 (&acc)[2][2][4][2], const Unit& u, int wr, int wc, int fr, int fq) const {
        const int pn = u.pn; size_t off; int ldc = 1024, ct; float sc = 1.f;
        if (pn < 4) { off = WS_QK; ct = pn; } else if (pn < 8) { off = WS_MV; ct = pn - 4; } else if (pn < 12) { off = WS_MO; ct = pn - 8; }
        else if (pn < 16) { off = WS_AQ; ct = pn - 12; sc = C2; } else if (pn == 16) { off = WS_AKV; ct = 0; ldc = 256; }
        else if (pn < 21) { off = WS_GM; ct = pn - 17; } else { off = WS_GA; ct = pn - 21; }
        bf16_t* base = (bf16_t*)(ws + off);
        const int row0 = u.pm * 256 + wr * 64 + fr, col0 = ct * 256 + wc * 32 + 8 * fq;
#pragma unroll
        for (int ai = 0; ai < 2; ++ai)
#pragma unroll
            for (int m = 0; m < 4; ++m) { bf16_t* rowp = base + (size_t)(row0 + ai * 128 + m * 16) * ldc + col0;
#pragma unroll
                for (int bj = 0; bj < 2; ++bj) { const A4 v0 = acc[ai][bj][m][0] * sc, v1 = acc[ai][bj][m][1] * sc; u32x4 w;
                    w.x = cvt_pk_bf16(v0[0], v0[1]); w.y = cvt_pk_bf16(v0[2], v0[3]); w.z = cvt_pk_bf16(v1[0], v1[1]); w.w = cvt_pk_bf16(v1[2], v1[3]);
                    *(u32x4*)(rowp + bj * 128) = w; } }
    }
};
struct EpiT1 {
    static constexpr bool PERM = true, AFTER_DRAIN = false;
    bf16_t* O;
    DI void operator()(const A4 (&acc)[2][2][4][2], const Unit& u, int wr, int wc, int fr, int fq) const {
        const int row0 = u.pm * 256 + wr * 64 + fr, col0 = u.pn * 256 + wc * 32 + 8 * fq;
#pragma unroll
        for (int ai = 0; ai < 2; ++ai)
#pragma unroll
            for (int m = 0; m < 4; ++m) { bf16_t* rowp = O + (size_t)(row0 + ai * 128 + m * 16) * 1024 + col0;
#pragma unroll
                for (int bj = 0; bj < 2; ++bj) { const A4 v0 = acc[ai][bj][m][0], v1 = acc[ai][bj][m][1]; u32x4 w;
                    w.x = cvt_pk_bf16(v0[0], v0[1]); w.y = cvt_pk_bf16(v0[2], v0[3]); w.z = cvt_pk_bf16(v1[0], v1[1]); w.w = cvt_pk_bf16(v1[2], v1[3]);
                    *(u32x4*)(rowp + bj * 128) = w; } }
    }
};
struct EpiPLE {
    static constexpr bool PERM = true, AFTER_DRAIN = false;
    const bf16_t* T1; bf16_t* O;
    DI void operator()(const A4 (&acc)[2][2][4][2], const Unit& u, int wr, int wc, int fr, int fq) const {
        const int row0 = u.pm * 256 + wr * 64 + fr, col0 = u.pn * 256 + wc * 32 + 8 * fq;
#pragma unroll
        for (int ai = 0; ai < 2; ++ai)
#pragma unroll
            for (int m = 0; m < 4; ++m) { const size_t ro = (size_t)(row0 + ai * 128 + m * 16) * 1024 + col0;
#pragma unroll
                for (int bj = 0; bj < 2; ++bj) { const A4 v0 = acc[ai][bj][m][0], v1 = acc[ai][bj][m][1];
                    float t[8]; unpack8(*(const u32x4*)(T1 + ro + bj * 128), t); float o[8];
#pragma unroll
                    for (int i = 0; i < 4; ++i) { o[i] = sigmoidf_(v0[i]) * t[i]; o[4 + i] = sigmoidf_(v1[i]) * t[4 + i]; }
                    *(u32x4*)(O + ro + bj * 128) = pack8(o); } }
    }
};
struct EpiU1 {
    static constexpr bool PERM = true, AFTER_DRAIN = false;
    const bf16_t* XN; float* O;
    DI void operator()(const A4 (&acc)[2][2][4][2], const Unit& u, int wr, int wc, int fr, int fq) const {
        const int row0 = u.pm * 256 + wr * 64 + fr, col0 = u.pn * 256 + wc * 32 + 8 * fq;
#pragma unroll
        for (int ai = 0; ai < 2; ++ai)
#pragma unroll
            for (int m = 0; m < 4; ++m) { const size_t ro = (size_t)(row0 + ai * 128 + m * 16) * 1024 + col0;
#pragma unroll
                for (int bj = 0; bj < 2; ++bj) { const A4 v0 = acc[ai][bj][m][0], v1 = acc[ai][bj][m][1];
                    float t[8]; unpack8(*(const u32x4*)(XN + ro + bj * 128), t);
                    A4 o0, o1;
#pragma unroll
                    for (int i = 0; i < 4; ++i) { o0[i] = ALPHA * t[i] + v0[i]; o1[i] = ALPHA * t[4 + i] + v1[i]; }
                    *(A4*)(O + ro + bj * 128) = o0; *(A4*)(O + ro + bj * 128 + 4) = o1; } }
    }
};
struct EpiGU {
    static constexpr bool PERM = true, AFTER_DRAIN = false;
    bf16_t* O;
    DI void operator()(const A4 (&acc)[2][2][4][2], const Unit& u, int wr, int wc, int fr, int fq) const {
        const int row0 = u.pm * 256 + wr * 64 + fr, col0 = u.pn * 128 + wc * 32 + 8 * fq;
#pragma unroll
        for (int ai = 0; ai < 2; ++ai)
#pragma unroll
            for (int m = 0; m < 4; ++m) { bf16_t* rowp = O + (size_t)(row0 + ai * 128 + m * 16) * DFF + col0;
                const A4 g0 = acc[ai][0][m][0], g1 = acc[ai][0][m][1], u0 = acc[ai][1][m][0], u1 = acc[ai][1][m][1]; float o[8];
#pragma unroll
                for (int i = 0; i < 4; ++i) { o[i] = siluf_(g0[i]) * u0[i]; o[4 + i] = siluf_(g1[i]) * u1[i]; }
                *(u32x4*)rowp = pack8(o); }
    }
};
struct EpiDN {
    static constexpr bool PERM = true, AFTER_DRAIN = false;
    const bf16_t* X1; const bf16_t* PLE; float* O;
    DI void operator()(const A4 (&acc)[2][2][4][2], const Unit& u, int wr, int wc, int fr, int fq) const {
        const int row0 = u.pm * 256 + wr * 64 + fr, col0 = u.pn * 256 + wc * 32 + 8 * fq;
#pragma unroll
        for (int ai = 0; ai < 2; ++ai)
#pragma unroll
            for (int m = 0; m < 4; ++m) { const int row = row0 + ai * 128 + m * 16; const size_t ro = (size_t)row * 1024 + col0;
                if (row < NTOK) {
#pragma unroll
                for (int bj = 0; bj < 2; ++bj) { const A4 v0 = acc[ai][bj][m][0], v1 = acc[ai][bj][m][1];
                    float t[8], p[8]; unpack8(*(const u32x4*)(X1 + ro + bj * 128), t); unpack8(*(const u32x4*)(PLE + ro + bj * 128), p);
                    A4 o0, o1;
#pragma unroll
                    for (int i = 0; i < 4; ++i) { o0[i] = ALPHA * t[i] + v0[i] + p[i]; o1[i] = ALPHA * t[4 + i] + v1[i] + p[4 + i]; }
                    *(A4*)(O + ro + bj * 128) = o0; *(A4*)(O + ro + bj * 128 + 4) = o1; } } }
    }
};
}

#define GAS __attribute__((address_space(1)))
typedef GAS unsigned gu32;
#define XB_TMO      128
#define XB_XCNT(j)  (256  + 64 * (j))
#define XB_XSUB(j)  (1280 + 64 * (j))
#define XB_XGEN(j)  (2304 + 64 * (j))
#define XB_TOP      3328
#define XB_TOPGEN   3392
#define XCD_BAR_WORDS 3456
#define XB_SPIN_CAP (1u << 18)

__device__ __forceinline__ unsigned xb_ld(unsigned* p)              { return __hip_atomic_load(p, __ATOMIC_RELAXED, __HIP_MEMORY_SCOPE_AGENT); }
__device__ __forceinline__ unsigned xb_add(unsigned* p, unsigned v) { return __hip_atomic_fetch_add(p, v, __ATOMIC_RELAXED, __HIP_MEMORY_SCOPE_AGENT); }
__device__ __forceinline__ unsigned xb_xcc_id() { return (unsigned)__builtin_amdgcn_s_getreg((3 << 11) | 20) & 0xFu; }
#define XB_SPIN(cond, bar) do { unsigned _sp = 0; while (cond) { __builtin_amdgcn_s_sleep(1); \
    if ((++_sp & 255u) == 0u) { if (xb_ld(&(bar)[XB_TMO])) break; if (_sp > XB_SPIN_CAP) { atomicAdd(&(bar)[XB_TMO], 1u); break; } } } } while (0)

struct XcdBarrier {
    unsigned* bar; unsigned x;
    volatile LAS unsigned* st;
};

__device__ __forceinline__ XcdBarrier xcd_barrier_post(unsigned* bar, volatile LAS unsigned* st) {
    XcdBarrier b; b.bar = bar; b.x = xb_xcc_id(); b.st = st;
    if (threadIdx.x == 0) (void)xb_add(&bar[XB_XCNT(b.x)], 1u);
    return b;
}
__device__ __forceinline__ void xcd_barrier_complete(unsigned* bar, unsigned x, unsigned& nloc, unsigned& nx) {
    const unsigned G = gridDim.x * gridDim.y * gridDim.z;
    unsigned sum, cnt, mine, sp = 0u;
    for (;;) {
        sum = 0u; cnt = 0u; mine = 0u;
#pragma unroll
        for (unsigned j = 0; j < 16; ++j) { const unsigned c = xb_ld(&bar[XB_XCNT(j)]); sum += c; cnt += (c > 0u) ? 1u : 0u; mine = (j == x) ? c : mine; }
        if (sum == G) break;
        __builtin_amdgcn_s_sleep(1);
        if ((++sp & 255u) == 0u) { if (xb_ld(&bar[XB_TMO])) break; if (sp > XB_SPIN_CAP) { atomicAdd(&bar[XB_TMO], 1u); break; } }
    }
    nloc = mine > 0u ? mine : 1u; nx = cnt > 0u ? cnt : 1u;
}

__device__ __forceinline__ void xcd_barrier(const XcdBarrier& b) {
    asm volatile("s_waitcnt vmcnt(0)" ::: "memory");
    __syncthreads();
    if (threadIdx.x == 0) {
        unsigned* bar = b.bar;
        __builtin_amdgcn_s_waitcnt(0);
        unsigned nloc = b.st[0], nx = b.st[1];
        if (nloc == 0u) { xcd_barrier_complete(bar, b.x, nloc, nx); b.st[0] = nloc; b.st[1] = nx; }
        const unsigned old = xb_add(&bar[XB_XSUB(b.x)], 1u);
        const unsigned gen = old / nloc;
        if (old + 1u == (gen + 1u) * nloc) {
            __builtin_amdgcn_fence(__ATOMIC_RELEASE, "agent");
            asm volatile("s_waitcnt vmcnt(0)" ::: "memory");
            const unsigned og = xb_add(&bar[XB_TOP], 1u);
            const unsigned tg = og / nx;
            if (og + 1u == (tg + 1u) * nx) xb_add(&bar[XB_TOPGEN], 1u);
            else XB_SPIN(xb_ld(&bar[XB_TOPGEN]) == tg, bar);
            __builtin_amdgcn_fence(__ATOMIC_ACQUIRE, "agent");
            xb_add(&bar[XB_XGEN(b.x)], 1u);
            asm volatile("s_waitcnt vmcnt(0)" ::: "memory");
        } else {
            XB_SPIN(xb_ld(&bar[XB_XGEN(b.x)]) == gen, bar);
            __builtin_amdgcn_fence(__ATOMIC_ACQUIRE, "agent");
            asm volatile("s_waitcnt vmcnt(0)" ::: "memory");
        }
    }
    __syncthreads();
}

struct Args { const float* in[28]; float* out; unsigned char* ws; };
struct Frame {
    LAS unsigned char* lds; int tid, lane, wave, G, bid;
    float* out; unsigned char* ws;
};
DI const float* inptr(int i) { int off = 8 * i; asm volatile("" : "+s"(off)); return *(const float* const*)((const unsigned char*)__builtin_amdgcn_kernarg_segment_ptr() + off); }
#define IN_XP 0
#define IN_XS 1
#define IN_C0 2
#define IN_N0 3
#define IN_M0 4
#define IN_CONV0 5
#define IN_CK 6
#define IN_CV 7
#define IN_PP 8
#define IN_PS 9
#define IN_LNG 10
#define IN_LNB 11
#define IN_WIN 12
#define IN_BI 13
#define IN_BF 14
#define IN_CW 15
#define IN_CB 16
#define IN_MNG 17
#define IN_SINK 18
#define IN_WOUT 19
#define IN_LN1G 20
#define IN_LN1B 21
#define IN_WGU 22
#define IN_WDN 23
#define IN_LN2G 24
#define IN_LN2B 25
#define IN_WPLE 26
#define IN_WPG 27

DI void p0_transpose_item(const float* W, int ldw, int src_col0, bf16_t* WT, int K, int dst_row0, int k0, LAS float* scr, int lane) {
#pragma unroll 8
    for (int i = 0; i < 32; ++i) { const int kk = 2 * i + (lane >> 5); scr[kk * 33 + (lane & 31)] = W[(size_t)(k0 + kk) * ldw + src_col0 + (lane & 31)]; }
    LDS_WAIT();
    const int c = lane & 7;
#pragma unroll
    for (int j = 0; j < 4; ++j) { const int n = (lane >> 3) + 8 * j; const LAS float* s = scr + (8 * c) * 33 + n;
        u32x4 o; o.x = cvt_pk_bf16(s[0 * 33], s[1 * 33]); o.y = cvt_pk_bf16(s[2 * 33], s[3 * 33]); o.z = cvt_pk_bf16(s[4 * 33], s[5 * 33]); o.w = cvt_pk_bf16(s[6 * 33], s[7 * 33]);
        *(u32x4*)(WT + (size_t)(dst_row0 + n) * K + k0 + 8 * c) = o; }
    LDS_WAIT();
}
DI void p0_prologue(Frame& F) {
    LAS float* wgT = (LAS float*)(F.lds + 73728);
    for (int idx = F.tid; idx < 8192; idx += 512) { const int c = idx & 7, k = idx >> 3; wgT[c * 1024 + k] = inptr(IN_WIN)[(size_t)k * INW + 2048 + c]; }
    LAS float* scr = (LAS float*)(F.lds + F.wave * 8704);
    const int gw = F.bid * 8 + F.wave, NGW = F.G * 8;
    bf16_t* Win_t = (bf16_t*)(F.ws + WS_WIN); bf16_t* Wout_t = (bf16_t*)(F.ws + WS_WOUT); bf16_t* Wgu_t = (bf16_t*)(F.ws + WS_WGU);
    bf16_t* Wdn_t = (bf16_t*)(F.ws + WS_WDN); bf16_t* Wple_t = (bf16_t*)(F.ws + WS_WPLE); bf16_t* Wpg_t = (bf16_t*)(F.ws + WS_WPG);
    constexpr int I_IN = 16 * 200, I_OUT = 16 * 32, I_GU = 16 * 176, I_DN = 44 * 32, I_PLE = 4 * 32, I_PG = 16 * 32;
    constexpr int NITEMS = I_IN + I_OUT + I_GU + I_DN + I_PLE + I_PG;
    for (int it = gw; it < NITEMS; it += NGW) {
        int r = it;
        if (r < I_IN) { const int kb = r / 200, n0 = 32 * (r % 200); p0_transpose_item(inptr(IN_WIN), INW, n0 + (n0 >= 2048 ? 8 : 0), Win_t, 1024, n0, 64 * kb, scr, F.lane); continue; } r -= I_IN;
        if (r < I_OUT) { const int kb = r / 32, n0 = 32 * (r % 32); p0_transpose_item(inptr(IN_WOUT), 1024, n0, Wout_t, 1024, n0, 64 * kb, scr, F.lane); continue; } r -= I_OUT;
        if (r < I_GU) { const int kb = r / 176, n0 = 32 * (r % 176); const int pn = n0 >> 8, rr = n0 & 255; const int src = rr < 128 ? 128 * pn + rr : DFF + 128 * pn + rr - 128;
            p0_transpose_item(inptr(IN_WGU), 2 * DFF, src, Wgu_t, 1024, n0, 64 * kb, scr, F.lane); continue; } r -= I_GU;
        if (r < I_DN) { const int kb = r / 32, n0 = 32 * (r % 32); p0_transpose_item(inptr(IN_WDN), 1024, n0, Wdn_t, DFF, n0, 64 * kb, scr, F.lane); continue; } r -= I_DN;
        if (r < I_PLE) { const int kb = r / 32, n0 = 32 * (r % 32); p0_transpose_item(inptr(IN_WPLE), 1024, n0, Wple_t, PD, n0, 64 * kb, scr, F.lane); continue; } r -= I_PLE;
        { const int kb = r / 32, n0 = 32 * (r % 32); p0_transpose_item(inptr(IN_WPG), 1024, n0, Wpg_t, 1024, n0, 64 * kb, scr, F.lane); }
    }
    __syncthreads();
    bf16_t* XN = (bf16_t*)(F.ws + WS_XN); float* GT = (float*)(F.ws + WS_GT);
    f32x4 g4[4], b4[4];
#pragma unroll
    for (int j = 0; j < 4; ++j) { g4[j] = *(const f32x4*)(inptr(IN_LNG) + 4 * F.lane + 256 * j); b4[j] = *(const f32x4*)(inptr(IN_LNB) + 4 * F.lane + 256 * j); }
    const float gbias = F.lane < 4 ? inptr(IN_BI)[F.lane] : (F.lane < 8 ? inptr(IN_BF)[F.lane - 4] : 0.f);
    for (int m = gw; m < MP; m += NGW) {
        unsigned long long* o8 = (unsigned long long*)(XN + (size_t)m * 1024) + F.lane;
        if (m >= NTOK) {
#pragma unroll
            for (int j = 0; j < 4; ++j) o8[64 * j] = 0ull;
            if (F.lane < 8) GT[(size_t)m * 8 + F.lane] = 0.f;
            continue;
        }
        const float* src = m < NP ? inptr(IN_XP) + (size_t)m * 1024 : inptr(IN_XS) + (size_t)(m - NP) * 1024;
        f32x4 v[4]; float s = 0.f;
#pragma unroll
        for (int j = 0; j < 4; ++j) { v[j] = *(const f32x4*)(src + 4 * F.lane + 256 * j); s += (v[j].x + v[j].y) + (v[j].z + v[j].w); }
        const float mean = wave_sum(s) * (1.f / 1024.f); float s2 = 0.f;
#pragma unroll
        for (int j = 0; j < 4; ++j) { v[j] = v[j] - mean; s2 += (v[j].x * v[j].x + v[j].y * v[j].y) + (v[j].z * v[j].z + v[j].w * v[j].w); }
        const float rstd = 1.f / sqrtf(wave_sum(s2) * (1.f / 1024.f) + LN_EPS);
#pragma unroll
        for (int j = 0; j < 4; ++j) { v[j] = v[j] * rstd * g4[j] + b4[j];
            o8[64 * j] = (unsigned long long)cvt_pk_bf16(v[j].x, v[j].y) | ((unsigned long long)cvt_pk_bf16(v[j].z, v[j].w) << 32); }
        float mine = 0.f;
#pragma unroll
        for (int c = 0; c < 8; ++c) { float a = 0.f;
#pragma unroll
            for (int j = 0; j < 4; ++j) { const f32x4 w = *(const LAS f32x4*)(wgT + c * 1024 + 4 * F.lane + 256 * j); a += (v[j].x * w.x + v[j].y * w.y) + (v[j].z * w.z + v[j].w * w.w); }
            a = wave_sum(a); if (F.lane == c) mine = a; }
        if (F.lane < 8) GT[(size_t)m * 8 + F.lane] = mine + gbias;
    }
}

DI void gate_scan(const float* GT, int b, int h, int j, LAS float* sG, LAS float* sA, LAS float* sM, LAS float* tmp, int tid) {
    float li = 0.f;
    if (tid < 256) { const size_t row = (size_t)b * SEQ + j * 256 + tid; const float f = GT[row * 8 + 4 + h]; li = GT[row * 8 + h];
        tmp[tid] = fminf(f, 0.f) - log1pf(expf(-fabsf(f))); }
    __syncthreads();
    int cur = 0;
    for (int off = 1; off < 256; off <<= 1) {
        if (tid < 256) { float v = tmp[cur * 256 + tid]; if (tid >= off) v += tmp[cur * 256 + tid - off]; tmp[(cur ^ 1) * 256 + tid] = v; }
        __syncthreads(); cur ^= 1;
    }
    float Gv = 0.f, av = 0.f;
    if (tid < 256) { Gv = tmp[cur * 256 + tid]; av = li - Gv; }
    __syncthreads();
    if (tid < 256) { sG[tid] = Gv; sA[tid] = av; tmp[tid] = av; }
    __syncthreads();
    cur = 0;
    for (int off = 1; off < 256; off <<= 1) {
        if (tid < 256) { float v = tmp[cur * 256 + tid]; if (tid >= off) v = fmaxf(v, tmp[cur * 256 + tid - off]); tmp[(cur ^ 1) * 256 + tid] = v; }
        __syncthreads(); cur ^= 1;
    }
    if (tid < 256) sM[tid] = tmp[cur * 256 + tid];
    __syncthreads();
}
DI void conv8(const bf16_t* QK, size_t rowbase, int tseq, int cglob, const LAS float* cwl, int cl, float (&out)[8]) {
    float a[8];
#pragma unroll
    for (int e = 0; e < 8; ++e) a[e] = cwl[4 * 128 + cl + e];
#pragma unroll
    for (int jj = 0; jj < 4; ++jj) { const int tt = tseq - 3 + jj;
        if (tt >= 0) { float x[8]; unpack8(*(const u32x4*)(QK + (rowbase + tt) * 1024 + cglob), x);
#pragma unroll
            for (int e = 0; e < 8; ++e) a[e] += cwl[jj * 128 + cl + e] * x[e]; } }
#pragma unroll
    for (int e = 0; e < 8; ++e) out[e] = siluf_(a[e]);
}
DI void load_convw(const Frame& F, LAS float* cwl, int cbase) {
    for (int idx = F.tid; idx < 640; idx += 512) { const int jj = idx >> 7, c = idx & 127; cwl[idx] = jj < 4 ? inptr(IN_CW)[jj * 1024 + cbase + c] : inptr(IN_CB)[cbase + c]; }
}
DI void stage_vt(const bf16_t* MV, size_t row0, int h, LAS bf16_t* VT, int tid) {
    const int s = tid & 63, vg = tid >> 6;
    const bf16_t* src = MV + (row0 + s) * 1024 + h * 256 + 32 * vg;
#pragma unroll
    for (int q = 0; q < 4; ++q) { const u32x4 w = *(const u32x4*)(src + 8 * q); LAS bf16_t* d = VT + (32 * vg + 8 * q) * 72 + s;
        d[0 * 72] = (bf16_t)(w.x & 0xffff); d[1 * 72] = (bf16_t)(w.x >> 16); d[2 * 72] = (bf16_t)(w.y & 0xffff); d[3 * 72] = (bf16_t)(w.y >> 16);
        d[4 * 72] = (bf16_t)(w.z & 0xffff); d[5 * 72] = (bf16_t)(w.z >> 16); d[6 * 72] = (bf16_t)(w.w & 0xffff); d[7 * 72] = (bf16_t)(w.w >> 16); }
}

DI void mlstm_a_item(Frame& F, int it) {
    const int b = it >> 6, h = (it >> 4) & 3, j = it & 15, bh = b * 4 + h;
    const int tid = launder_v(F.tid), lane = tid & 63, wid = F.wave, r = lane & 31, hh = lane >> 5;
    LAS float* sG = (LAS float*)(F.lds + 0); LAS float* sA = (LAS float*)(F.lds + 1024); LAS float* sM = (LAS float*)(F.lds + 2048);
    LAS float* tmp = (LAS float*)(F.lds + 3072); LAS float* sWs = (LAS float*)(F.lds + 5120); LAS float* cwk = (LAS float*)(F.lds + 6144);
    LAS bf16_t* KWT = (LAS bf16_t*)(F.lds + 16384); LAS bf16_t* VT = (LAS bf16_t*)(F.lds + 34816);
    const float* GT = (const float*)(F.ws + WS_GT); const bf16_t* QK = (const bf16_t*)(F.ws + WS_QK); const bf16_t* MV = (const bf16_t*)(F.ws + WS_MV);
    gate_scan(GT, b, h, j, sG, sA, sM, tmp, tid);
    const float amax = sM[255];
    if (tid < 256) sWs[tid] = expf(sA[tid] - amax) * KSCALE;
    load_convw(F, cwk, 512 + 128 * h);
    __syncthreads();
    f32x16 acc[2][2];
#pragma unroll
    for (int i = 0; i < 2; ++i)
#pragma unroll
        for (int jn = 0; jn < 2; ++jn)
#pragma unroll
            for (int e = 0; e < 16; ++e) acc[i][jn][e] = 0.f;
    float dn = 0.f;
    const int wr = wid >> 2, wc = wid & 3;
    for (int ch = 0; ch < 4; ++ch) {
        { const int s = tid & 63, dg = tid >> 6, tokl = ch * 64 + s, tseq = j * 256 + tokl; const float w = sWs[tokl];
#pragma unroll
            for (int q = 0; q < 2; ++q) { float kc[8]; conv8(QK, (size_t)b * SEQ, tseq, 512 + 128 * h + 16 * dg + 8 * q, cwk, 16 * dg + 8 * q, kc);
#pragma unroll
                for (int e = 0; e < 8; ++e) KWT[(16 * dg + 8 * q + e) * 72 + s] = bf1(kc[e] * w); } }
        stage_vt(MV, (size_t)b * SEQ + j * 256 + ch * 64, h, VT, tid);
        __syncthreads();
#pragma unroll
        for (int ks = 0; ks < 4; ++ks) { bf16x8 a[2], bb[2];
#pragma unroll
            for (int i = 0; i < 2; ++i) a[i] = *(const LAS bf16x8*)(KWT + (wr * 64 + i * 32 + r) * 72 + 16 * ks + 8 * hh);
#pragma unroll
            for (int jn = 0; jn < 2; ++jn) bb[jn] = *(const LAS bf16x8*)(VT + (wc * 64 + jn * 32 + r) * 72 + 16 * ks + 8 * hh);
#pragma unroll
            for (int i = 0; i < 2; ++i)
#pragma unroll
                for (int jn = 0; jn < 2; ++jn) acc[i][jn] = MFMA32(a[i], bb[jn], acc[i][jn]); }
        if (tid < 128) {
#pragma unroll
            for (int q = 0; q < 8; ++q) { float x[8]; unpack8(*(const LAS u32x4*)(KWT + tid * 72 + 8 * q), x);
#pragma unroll
                for (int e = 0; e < 8; ++e) dn += x[e]; } }
        __syncthreads();
    }
    float* dC = F.out + O_DC + ((size_t)bh * 16 + j) * 32768;
#pragma unroll
    for (int i = 0; i < 2; ++i)
#pragma unroll
        for (int jn = 0; jn < 2; ++jn)
#pragma unroll
            for (int e = 0; e < 16; ++e) dC[(size_t)(wr * 64 + i * 32 + crow(e, hh)) * 256 + wc * 64 + jn * 32 + r] = acc[i][jn][e];
    if (tid < 128) ((float*)(F.ws + WS_SM + SM_DN))[(bh * 16 + j) * 128 + tid] = dn;
    if (tid == 0) { ((float*)(F.ws + WS_SM + SM_G))[bh * 16 + j] = sG[255]; ((float*)(F.ws + WS_SM + SM_MLOC))[bh * 16 + j] = amax + sG[255]; }
    __syncthreads();
}

DI void attn_unit(Frame& F, int it, bf16_t* Odst) {
    const int b = it >> 7, kvh = (it >> 6) & 1, qt = it & 63, q0 = qt * 64;
    const int tid = launder_v(F.tid), lane = tid & 63, wid = F.wave, r = lane & 31, hh = lane >> 5;
    LAS bf16_t* Kn = (LAS bf16_t*)(F.lds + 0);
    LAS bf16_t* VT = (LAS bf16_t*)(F.lds + 27648);
    LAS bf16_t* stg = (LAS bf16_t*)(F.lds + 53248 + wid * 4608);
    const bf16_t* AQ = (const bf16_t*)(F.ws + WS_AQ); const bf16_t* AKV = (const bf16_t*)(F.ws + WS_AKV);
    const size_t rowb = (size_t)b * SEQ;
#pragma unroll
    for (int i = 0; i < 3; ++i) { const int id = tid + 512 * i, kk = id >> 3, ch = id & 7, tk = q0 - 128 + kk;
        u32x4 w = (u32x4){0u, 0u, 0u, 0u}; if (tk >= 0) w = *(const u32x4*)(AKV + (rowb + tk) * 256 + kvh * 64 + 8 * ch);
        *(LAS u32x4*)(Kn + kk * 72 + 8 * ch) = w; }
#pragma unroll
    for (int i = 0; i < 3; ++i) { const int id = tid + 512 * i, kk = id % 192, ch = id / 192, tk = q0 - 128 + kk;
        u32x4 w = (u32x4){0u, 0u, 0u, 0u}; if (tk >= 0) w = *(const u32x4*)(AKV + (rowb + tk) * 256 + 128 + kvh * 64 + 8 * ch);
        LAS bf16_t* d = VT + (8 * ch) * 200 + kk;
        d[0 * 200] = (bf16_t)(w.x & 0xffff); d[1 * 200] = (bf16_t)(w.x >> 16); d[2 * 200] = (bf16_t)(w.y & 0xffff); d[3 * 200] = (bf16_t)(w.y >> 16);
        d[4 * 200] = (bf16_t)(w.z & 0xffff); d[5 * 200] = (bf16_t)(w.z >> 16); d[6 * 200] = (bf16_t)(w.w & 0xffff); d[7 * 200] = (bf16_t)(w.w >> 16); }
    __syncthreads();
    const int hq = kvh * 8 + wid;
    const float sink2 = inptr(IN_SINK)[hq] * LOG2E;
    for (int gi = 0; gi < 2; ++gi) {
        const int tq = q0 + 32 * gi;
        bf16x8 qf[4];
#pragma unroll
        for (int ks = 0; ks < 4; ++ks) qf[ks] = *(const bf16x8*)(AQ + (rowb + tq + r) * 1024 + hq * 64 + 16 * ks + 8 * hh);
        f32x16 st[5];
#pragma unroll
        for (int kt = 0; kt < 5; ++kt) {
#pragma unroll
            for (int e = 0; e < 16; ++e) st[kt][e] = 0.f;
#pragma unroll
            for (int ks = 0; ks < 4; ++ks) { const bf16x8 a = *(const LAS bf16x8*)(Kn + (32 * gi + 32 * kt + r) * 72 + 16 * ks + 8 * hh); st[kt] = MFMA32(a, qf[ks], st[kt]); } }
        float mx = -INFINITY;
        if (q0 < 128) {
#pragma unroll
            for (int kt = 0; kt < 5; ++kt) { const int kb = q0 - 128 + 32 * gi + 32 * kt + 4 * hh;
#pragma unroll
                for (int e = 0; e < 16; ++e) if (kb + (e & 3) + 8 * (e >> 2) < 0) st[kt][e] = -INFINITY;
                __builtin_amdgcn_sched_barrier(0); }
        }
#pragma unroll
        for (int e = 0; e < 16; ++e) if (crow(e, hh) < r) st[0][e] = -INFINITY;
        __builtin_amdgcn_sched_barrier(0);
#pragma unroll
        for (int e = 0; e < 16; ++e) if (crow(e, hh) > r) st[4][e] = -INFINITY;
        __builtin_amdgcn_sched_barrier(0);
#pragma unroll
        for (int kt = 0; kt < 5; ++kt)
#pragma unroll
            for (int e = 0; e < 16; ++e) mx = fmaxf(mx, st[kt][e]);
        mx = fmaxf(mx, __shfl_xor(mx, 32)); mx = fmaxf(mx, sink2);
        float sum = 0.f;
#pragma unroll
        for (int kt = 0; kt < 5; ++kt)
#pragma unroll
            for (int e = 0; e < 16; ++e) { const float ev = __builtin_amdgcn_exp2f(st[kt][e] - mx); st[kt][e] = ev; sum += ev; }
        sum += __shfl_xor(sum, 32);
        const float rinv = 1.f / (sum + __builtin_amdgcn_exp2f(sink2 - mx));
        f32x16 o[2];
#pragma unroll
        for (int dn = 0; dn < 2; ++dn)
#pragma unroll
            for (int e = 0; e < 16; ++e) o[dn][e] = 0.f;
#pragma unroll
        for (int kt = 0; kt < 5; ++kt)
#pragma unroll
            for (int s2 = 0; s2 < 2; ++s2) { u32x4 pw;
                pw.x = cvt_pk_bf16(st[kt][8 * s2 + 0] * rinv, st[kt][8 * s2 + 1] * rinv); pw.y = cvt_pk_bf16(st[kt][8 * s2 + 2] * rinv, st[kt][8 * s2 + 3] * rinv);
                pw.z = cvt_pk_bf16(st[kt][8 * s2 + 4] * rinv, st[kt][8 * s2 + 5] * rinv); pw.w = cvt_pk_bf16(st[kt][8 * s2 + 6] * rinv, st[kt][8 * s2 + 7] * rinv);
                const bf16x8 pa = __builtin_bit_cast(bf16x8, pw);
#pragma unroll
                for (int dn = 0; dn < 2; ++dn) { const LAS bf16_t* vp = VT + (dn * 32 + r) * 200 + 32 * gi + 32 * kt + 16 * s2 + 4 * hh;
                    const u32x2 lo = *(const LAS u32x2*)vp, hi = *(const LAS u32x2*)(vp + 8);
                    const u32x4 vb = (u32x4){lo.x, lo.y, hi.x, hi.y};
                    o[dn] = MFMA32(pa, __builtin_bit_cast(bf16x8, vb), o[dn]); } }
#pragma unroll
        for (int dn = 0; dn < 2; ++dn)
#pragma unroll
            for (int e = 0; e < 16; ++e) stg[crow(e, hh) * 72 + dn * 32 + r] = bf1(o[dn][e]);
        LDS_WAIT();
#pragma unroll
        for (int i = 0; i < 4; ++i) { const int id = lane + 64 * i, row = id >> 3, ch = id & 7; const u32x4 v = *(const LAS u32x4*)(stg + row * 72 + 8 * ch);
            *(u32x4*)(Odst + (rowb + tq + row) * 1024 + hq * 64 + 8 * ch) = v; }
        LDS_WAIT();
    }
    __syncthreads();
}

DI void sattn_item(Frame& F, int b) {
    const int tid = launder_v(F.tid);
    LAS float* Ks = (LAS float*)(F.lds + 0);
    LAS float* Vs = (LAS float*)(F.lds + 66564);
    LAS float* sQ = (LAS float*)(F.lds + 132612);
    LAS float* sP = (LAS float*)(F.lds + 136708);
    bf16_t* AQ = (bf16_t*)(F.ws + WS_AQ); const bf16_t* AKV = (const bf16_t*)(F.ws + WS_AKV);
    const size_t row = (size_t)NP + b;
    const float* ck = inptr(IN_CK) + (size_t)b * 16384; const float* cv = inptr(IN_CV) + (size_t)b * 16384;
    float* ks_o = F.out + O_KS + (size_t)b * 16384; float* vs_o = F.out + O_VS + (size_t)b * 16384;
    for (int idx = tid; idx < 16384; idx += 512) { const int kk = idx >> 7, c = idx & 127; const float kv = ck[idx], vv = cv[idx];
        Ks[kk * 129 + c] = kv; Vs[kk * 128 + c] = vv; if (kk >= 1) { ks_o[idx - 128] = kv; vs_o[idx - 128] = vv; } }
    if (tid < 128) { const float kn = bflo((unsigned)AKV[row * 256 + tid]), vn = bflo((unsigned)AKV[row * 256 + 128 + tid]);
        Ks[128 * 129 + tid] = kn; Vs[128 * 128 + tid] = vn; ks_o[127 * 128 + tid] = kn; vs_o[127 * 128 + tid] = vn; }
    for (int idx = tid; idx < 1024; idx += 512) sQ[idx] = bflo((unsigned)AQ[row * 1024 + idx]);
    __syncthreads();
    const int hq = tid >> 5, l = tid & 31, kvh = hq >> 3;
    { float sc[5]; float mx = -INFINITY;
#pragma unroll
        for (int i = 0; i < 5; ++i) { const int kk = l + 32 * i; float s = -INFINITY;
            if (kk < 129) { s = 0.f;
#pragma unroll 4
                for (int d = 0; d < 64; ++d) s += sQ[hq * 64 + d] * Ks[kk * 129 + kvh * 64 + d]; }
            sc[i] = s; mx = fmaxf(mx, s); asm volatile("" ::: "memory"); }
#pragma unroll
        for (int o = 1; o < 32; o <<= 1) mx = fmaxf(mx, __shfl_xor(mx, o));
        const float sink2 = inptr(IN_SINK)[hq] * LOG2E; mx = fmaxf(mx, sink2);
        float sum = 0.f;
#pragma unroll
        for (int i = 0; i < 5; ++i) { sc[i] = __builtin_amdgcn_exp2f(sc[i] - mx); sum += sc[i]; }
#pragma unroll
        for (int o = 1; o < 32; o <<= 1) sum += __shfl_xor(sum, o);
        const float rinv = 1.f / (sum + __builtin_amdgcn_exp2f(sink2 - mx));
#pragma unroll
        for (int i = 0; i < 5; ++i) { const int kk = l + 32 * i; if (kk < 129) sP[hq * 132 + kk] = sc[i] * rinv; } }
    __syncthreads();
    { float o0 = 0.f, o1 = 0.f;
#pragma unroll 4
        for (int kk = 0; kk < 129; ++kk) { const float p = sP[hq * 132 + kk]; o0 += p * Vs[kk * 128 + kvh * 64 + l]; o1 += p * Vs[kk * 128 + kvh * 64 + 32 + l]; }
        AQ[row * 1024 + hq * 64 + l] = bf1(o0); AQ[row * 1024 + hq * 64 + 32 + l] = bf1(o1); }
    __syncthreads();
}

DI void scan_item(Frame& F, int it) {
    const int bh = it >> 3, sl = it & 7, tid = launder_v(F.tid);
    const float* g = (const float*)(F.ws + WS_SM + SM_G) + bh * 16; const float* ml = (const float*)(F.ws + WS_SM + SM_MLOC) + bh * 16;
    float fa[16], fb[16], mj[17]; mj[0] = 0.f;
#pragma unroll
    for (int j = 0; j < 16; ++j) { const float gj = g[j], mlj = ml[j]; const float mn = fmaxf(gj + mj[j], mlj); fa[j] = expf(gj + mj[j] - mn); fb[j] = expf(mlj - mn); mj[j + 1] = mn; }
    const float* dC = F.out + O_DC + (size_t)bh * 16 * 32768; float* Cst = F.out + O_CST + (size_t)bh * 16 * 32768; float* Cp = F.out + O_CP + (size_t)bh * 32768;
#pragma unroll
    for (int q = 0; q < 2; ++q) { const int e0 = sl * 4096 + q * 2048 + tid * 4; f32x4 c = (f32x4){0.f, 0.f, 0.f, 0.f};
#pragma unroll
        for (int j = 0; j < 16; ++j) { *(f32x4*)(Cst + (size_t)j * 32768 + e0) = c; const f32x4 d = *(const f32x4*)(dC + (size_t)j * 32768 + e0); c = c * fa[j] + d * fb[j]; }
        *(f32x4*)(Cp + e0) = c; }
    if (sl == 0) {
        float* mst = (float*)(F.ws + WS_SM + SM_MST) + bh * 17;
        if (tid < 17) { float v = mj[0];
#pragma unroll
            for (int j = 1; j < 17; ++j) if (tid == j) v = mj[j];
            mst[tid] = v; if (tid == 16) F.out[O_MP + bh] = v; }
        if (tid < 128) { const float* dn = (const float*)(F.ws + WS_SM + SM_DN) + (size_t)bh * 16 * 128; float* nst = (float*)(F.ws + WS_SM + SM_NST) + (size_t)bh * 16 * 128; float n = 0.f;
#pragma unroll
            for (int j = 0; j < 16; ++j) { nst[j * 128 + tid] = n; n = n * fa[j] + dn[j * 128 + tid] * fb[j]; }
            F.out[O_NP + bh * 128 + tid] = n; }
    }
}

DI void mlstm_c_item(Frame& F, int it, bf16_t* Odst) {
    const int b = it >> 6, h = (it >> 4) & 3, j = it & 15, bh = b * 4 + h;
    const int tid = launder_v(F.tid), lane = tid & 63, wid = F.wave, r = lane & 31, hh = lane >> 5;
    LAS float* sG = (LAS float*)(F.lds + 0); LAS float* sA = (LAS float*)(F.lds + 1024); LAS float* sM = (LAS float*)(F.lds + 2048);
    LAS float* tmp = (LAS float*)(F.lds + 3072); LAS float* sU = (LAS float*)(F.lds + 5120); LAS float* cwk = (LAS float*)(F.lds + 6144);
    LAS float* cwq = (LAS float*)(F.lds + 8704); LAS float* sN = (LAS float*)(F.lds + 11264); LAS float* sQN = (LAS float*)(F.lds + 11776);
    LAS float* sRS = (LAS float*)(F.lds + 12032); LAS float* sInter = (LAS float*)(F.lds + 13056); LAS float* sRden = (LAS float*)(F.lds + 13312);
    LAS bf16_t* Qc = (LAS bf16_t*)(F.lds + 16384); LAS bf16_t* Kc = (LAS bf16_t*)(F.lds + 33792); LAS bf16_t* KWT = (LAS bf16_t*)(F.lds + 51200);
    LAS bf16_t* VT = (LAS bf16_t*)(F.lds + 69632); LAS bf16_t* W = (LAS bf16_t*)(F.lds + 106496); LAS float* H = (LAS float*)(F.lds + 16384);
    const float* GT = (const float*)(F.ws + WS_GT); const bf16_t* QK = (const bf16_t*)(F.ws + WS_QK); const bf16_t* MV = (const bf16_t*)(F.ws + WS_MV);
    const bf16_t* MO = (const bf16_t*)(F.ws + WS_MO); const bf16_t* YA = (const bf16_t*)(F.ws + WS_AQ); const bf16_t* GM = (const bf16_t*)(F.ws + WS_GM); const bf16_t* GA = (const bf16_t*)(F.ws + WS_GA);
    gate_scan(GT, b, h, j, sG, sA, sM, tmp, tid);
    const float m_start = ((const float*)(F.ws + WS_SM + SM_MST))[bh * 17 + j];
    if (tid < 256) sU[tid] = -fmaxf(m_start, sM[tid]);
    load_convw(F, cwk, 512 + 128 * h); load_convw(F, cwq, 128 * h);
    if (tid < 128) sN[tid] = ((const float*)(F.ws + WS_SM + SM_NST))[(bh * 16 + j) * 128 + tid];
    f32x16 Cacc[4];
    { const float* Cst = F.out + O_CST + ((size_t)bh * 16 + j) * 32768;
        const float* cb = Cst + (size_t)(4 * hh) * 256 + 32 * wid + r;
#pragma unroll
        for (int dt = 0; dt < 4; ++dt) {
#pragma unroll
            for (int e = 0; e < 16; ++e) Cacc[dt][e] = cb[(dt * 32 + (e & 3) + 8 * (e >> 2)) * 256];
            asm volatile("" ::: "memory"); } }
    __syncthreads();
    for (int c = 0; c < 4; ++c) {
        const float u_prev = (c == 0) ? -m_start : sU[64 * c - 1]; const float u_last = sU[64 * c + 63];
        const size_t row0 = (size_t)b * SEQ + j * 256 + c * 64;
        { const int s = tid & 63, dg = tid >> 6, tokl = 64 * c + s, tseq = j * 256 + tokl; const float wst = __expf(sA[tokl] + u_last) * KSCALE;
#pragma unroll
            for (int q = 0; q < 2; ++q) { float kc[8]; conv8(QK, (size_t)b * SEQ, tseq, 512 + 128 * h + 16 * dg + 8 * q, cwk, 16 * dg + 8 * q, kc);
                *(LAS u32x4*)(Kc + s * 136 + 16 * dg + 8 * q) = pack8(kc);
#pragma unroll
                for (int e = 0; e < 8; ++e) KWT[(16 * dg + 8 * q + e) * 72 + s] = bf1(kc[e] * wst); asm volatile("" ::: "memory"); } }
#pragma unroll
        for (int i = 0; i < 2; ++i) { const int idq = tid + 512 * i, t = idq >> 4, chq = idq & 15; float qc[8];
            conv8(QK, (size_t)b * SEQ, j * 256 + 64 * c + t, 128 * h + 8 * chq, cwq, 8 * chq, qc); *(LAS u32x4*)(Qc + t * 136 + 8 * chq) = pack8(qc); asm volatile("" ::: "memory"); }
        stage_vt(MV, row0, h, VT, tid);
        if (tid < 64) sInter[tid] = __expf(sU[64 * c + tid] - u_prev);
        __syncthreads();
        if (wid < 4) {
            const int si = wid >> 1, ti = wid & 1; f32x16 st;
#pragma unroll
            for (int e = 0; e < 16; ++e) st[e] = 0.f;
#pragma unroll
            for (int ks = 0; ks < 8; ++ks) { const bf16x8 a = *(const LAS bf16x8*)(Kc + (si * 32 + r) * 136 + 16 * ks + 8 * hh); const bf16x8 bq = *(const LAS bf16x8*)(Qc + (ti * 32 + r) * 136 + 16 * ks + 8 * hh);
                st = MFMA32(a, bq, st); }
            const int t = ti * 32 + r; const float ut = sU[64 * c + t]; float rs = 0.f;
#pragma unroll
            for (int g = 0; g < 4; ++g) { float w4[4];
#pragma unroll
                for (int i = 0; i < 4; ++i) { const int sl = si * 32 + 8 * g + 4 * hh + i; const float wv = (sl <= t) ? __expf(sA[64 * c + sl] + ut) * st[4 * g + i] * KSCALE : 0.f; rs += wv; w4[i] = wv; }
                *(LAS u32x2*)(W + t * 72 + si * 32 + 8 * g + 4 * hh) = (u32x2){cvt_pk_bf16(w4[0], w4[1]), cvt_pk_bf16(w4[2], w4[3])}; }
            sRS[(si * 2 + hh) * 64 + t] = rs;
        } else {
            const int tq = (tid - 256) >> 2, part = tid & 3; float v = 0.f;
#pragma unroll
            for (int q = 0; q < 4; ++q) { float x[8]; unpack8(*(const LAS u32x4*)(Qc + tq * 136 + 32 * part + 8 * q), x);
#pragma unroll
                for (int e = 0; e < 8; ++e) v += x[e] * sN[32 * part + 8 * q + e]; }
            v += __shfl_xor(v, 1); v += __shfl_xor(v, 2);
            if (part == 0) sQN[tq] = v;
        }
        __syncthreads();
        if (tid < 64) { const float den = (sRS[tid] + sRS[64 + tid]) + (sRS[128 + tid] + sRS[192 + tid]) + sInter[tid] * sQN[tid];
            sRden[tid] = 1.f / fmaxf(fabsf(den), __expf(sU[64 * c + tid] - sG[64 * c + tid])); }
        f32x16 Y[2];
#pragma unroll
        for (int i = 0; i < 2; ++i)
#pragma unroll
            for (int e = 0; e < 16; ++e) Y[i][e] = 0.f;
#pragma unroll
        for (int dt = 0; dt < 4; ++dt)
#pragma unroll
            for (int s2 = 0; s2 < 2; ++s2) { u32x4 cw;
                cw.x = cvt_pk_bf16(Cacc[dt][8 * s2 + 0], Cacc[dt][8 * s2 + 1]); cw.y = cvt_pk_bf16(Cacc[dt][8 * s2 + 2], Cacc[dt][8 * s2 + 3]);
                cw.z = cvt_pk_bf16(Cacc[dt][8 * s2 + 4], Cacc[dt][8 * s2 + 5]); cw.w = cvt_pk_bf16(Cacc[dt][8 * s2 + 6], Cacc[dt][8 * s2 + 7]);
                const bf16x8 bc = __builtin_bit_cast(bf16x8, cw);
#pragma unroll
                for (int i = 0; i < 2; ++i) { const LAS bf16_t* qp = Qc + (i * 32 + r) * 136 + dt * 32 + 16 * s2 + 4 * hh;
                    const u32x2 lo = *(const LAS u32x2*)qp, hi = *(const LAS u32x2*)(qp + 8); const u32x4 qa = (u32x4){lo.x, lo.y, hi.x, hi.y};
                    Y[i] = MFMA32(__builtin_bit_cast(bf16x8, qa), bc, Y[i]); } }
#pragma unroll
        for (int i = 0; i < 2; ++i)
#pragma unroll
            for (int e = 0; e < 16; ++e) Y[i][e] *= sInter[i * 32 + crow(e, hh)];
        bf16x8 bv[4];
#pragma unroll
        for (int ks = 0; ks < 4; ++ks) bv[ks] = *(const LAS bf16x8*)(VT + (32 * wid + r) * 72 + 16 * ks + 8 * hh);
#pragma unroll
        for (int ks = 0; ks < 4; ++ks)
#pragma unroll
            for (int i = 0; i < 2; ++i) { const bf16x8 a = *(const LAS bf16x8*)(W + (i * 32 + r) * 72 + 16 * ks + 8 * hh); Y[i] = MFMA32(a, bv[ks], Y[i]); }
        if (c < 3) {
            const float decay = sInter[63];
#pragma unroll
            for (int dt = 0; dt < 4; ++dt) {
#pragma unroll
                for (int e = 0; e < 16; ++e) Cacc[dt][e] *= decay;
#pragma unroll
                for (int ks = 0; ks < 4; ++ks) { const bf16x8 a = *(const LAS bf16x8*)(KWT + (dt * 32 + r) * 72 + 16 * ks + 8 * hh); Cacc[dt] = MFMA32(a, bv[ks], Cacc[dt]); } }
            if (tid < 128) { float sn = 0.f;
#pragma unroll
                for (int q = 0; q < 8; ++q) { float x[8]; unpack8(*(const LAS u32x4*)(KWT + tid * 72 + 8 * q), x);
#pragma unroll
                    for (int e = 0; e < 8; ++e) sn += x[e]; }
                sN[tid] = decay * sN[tid] + sn; }
        }
        __syncthreads();
#pragma unroll
        for (int i = 0; i < 2; ++i)
#pragma unroll
            for (int e = 0; e < 16; ++e) { const int t = i * 32 + crow(e, hh); H[t * 260 + 32 * wid + r] = Y[i][e] * sRden[t]; }
        __syncthreads();
        { const int t = tid >> 3, cgp = tid & 7; f32x4 hv[8]; float ss = 0.f;
#pragma unroll
            for (int q = 0; q < 8; ++q) { hv[q] = *(const LAS f32x4*)(H + t * 260 + 32 * cgp + 4 * q); ss += (hv[q].x * hv[q].x + hv[q].y * hv[q].y) + (hv[q].z * hv[q].z + hv[q].w * hv[q].w); }
            ss += __shfl_xor(ss, 1); ss += __shfl_xor(ss, 2); ss += __shfl_xor(ss, 4);
            const float rinv = rsqrtf(ss * (1.f / 256.f) + RMS_EPS);
            const size_t ro = (row0 + t) * 1024 + h * 256 + 32 * cgp; const float* mng = inptr(IN_MNG) + h * 256 + 32 * cgp;
#pragma unroll
            for (int q = 0; q < 4; ++q) { float mo[8], gm[8], ga[8], ya[8], o[8];
                unpack8(*(const u32x4*)(MO + ro + 8 * q), mo); unpack8(*(const u32x4*)(GM + ro + 8 * q), gm); unpack8(*(const u32x4*)(GA + ro + 8 * q), ga); unpack8(*(const u32x4*)(YA + ro + 8 * q), ya);
                const f32x4 g0 = *(const f32x4*)(mng + 8 * q), g1 = *(const f32x4*)(mng + 8 * q + 4);
#pragma unroll
                for (int e = 0; e < 8; ++e) { const float hval = (e < 4 ? hv[2 * q][e & 3] : hv[2 * q + 1][e & 3]) * rinv; const float gg = e < 4 ? g0[e & 3] : g1[e & 3];
                    const float ym = sigmoidf_(mo[e]) * hval * gg; o[e] = sigmoidf_(gm[e]) * ym + sigmoidf_(ga[e]) * ya[e]; }
                *(u32x4*)(Odst + ro + 8 * q) = pack8(o); asm volatile("" ::: "memory"); } }
        __syncthreads();
    }
}

DI void smlstm_item(Frame& F, int it) {
    const int b = it >> 2, h = it & 3, tid = launder_v(F.tid), lane = tid & 63, wid = F.wave;
    LAS float* sq = (LAS float*)(F.lds + 0); LAS float* sk = (LAS float*)(F.lds + 512); LAS float* sv = (LAS float*)(F.lds + 1024);
    LAS float* sred = (LAS float*)(F.lds + 2048);
    LAS float* part = (LAS float*)(F.lds + 4096);
    const size_t row = (size_t)NP + b;
    const bf16_t* QK = (const bf16_t*)(F.ws + WS_QK); const bf16_t* MV = (const bf16_t*)(F.ws + WS_MV); const float* GT = (const float*)(F.ws + WS_GT);
    const bf16_t* MO = (const bf16_t*)(F.ws + WS_MO); const bf16_t* YA = (const bf16_t*)(F.ws + WS_AQ); bf16_t* GM = (bf16_t*)(F.ws + WS_GM); const bf16_t* GA = (const bf16_t*)(F.ws + WS_GA);
    const float* n0 = inptr(IN_N0) + (size_t)(b * 4 + h) * 128;
    if (tid < 256) { const int c = tid < 128 ? 128 * h + tid : 512 + 128 * h + (tid - 128);
        const float x = bflo((unsigned)QK[row * 1024 + c]); const float* sc = inptr(IN_CONV0) + (size_t)b * 3072 + c; const float* cw = inptr(IN_CW) + c;
        const float y = cw[0] * sc[0] + cw[1024] * sc[1024] + cw[2048] * sc[2048] + cw[3072] * x + inptr(IN_CB)[c];
        const float val = siluf_(y);
        if (tid < 128) sq[tid] = val; else sk[tid - 128] = val * KSCALE;
        float* cs = F.out + O_CONVS + (size_t)b * 3072 + c; cs[0] = sc[1024]; cs[1024] = sc[2048]; cs[2048] = x;
    } else sv[tid - 256] = bflo((unsigned)MV[row * 1024 + h * 256 + (tid - 256)]);
    __syncthreads();
    if (wid == 0) { float a = sq[lane] * sk[lane] + sq[lane + 64] * sk[lane + 64]; float bq = sq[lane] * n0[lane] + sq[lane + 64] * n0[lane + 64];
        a = wave_sum(a); bq = wave_sum(bq); if (lane == 0) { sred[0] = a; sred[1] = bq; } }
    __syncthreads();
    const float qk = sred[0], qn = sred[1];
    const float ipre = GT[row * 8 + h], fpre = GT[row * 8 + 4 + h];
    const float logf = fminf(fpre, 0.f) - log1pf(expf(-fabsf(fpre)));
    const float m0 = inptr(IN_M0)[b * 4 + h]; const float m_inter = logf + m0, m_t = fmaxf(m_inter, ipre);
    const float wgt = expf(ipre - m_t), inter = expf(m_inter - m_t);
    { const int pt = tid >> 6, vq = tid & 63; const float* C0 = inptr(IN_C0) + (size_t)(b * 4 + h) * 32768; float* Cs = F.out + O_CS + (size_t)(b * 4 + h) * 32768;
        const f32x4 v4 = *(const LAS f32x4*)(sv + 4 * vq); f32x4 a4 = (f32x4){0.f, 0.f, 0.f, 0.f};
#pragma unroll 4
        for (int dd = 0; dd < 16; ++dd) { const int d = 16 * pt + dd; const f32x4 c4 = *(const f32x4*)(C0 + (size_t)d * 256 + 4 * vq); a4 = a4 + c4 * sq[d];
            *(f32x4*)(Cs + (size_t)d * 256 + 4 * vq) = c4 * inter + v4 * (wgt * sk[d]); }
        *(LAS f32x4*)(part + pt * 256 + 4 * vq) = a4; }
    if (tid < 128) F.out[O_NS + (size_t)(b * 4 + h) * 128 + tid] = inter * n0[tid] + wgt * sk[tid];
    if (tid == 0) F.out[O_MS + b * 4 + h] = m_t;
    __syncthreads();
    float hv = 0.f;
    if (tid < 256) { float qC = 0.f;
#pragma unroll
        for (int p = 0; p < 8; ++p) qC += part[p * 256 + tid];
        const float num = wgt * qk * sv[tid] + inter * qC; const float den = wgt * qk + inter * qn;
        hv = num / fmaxf(fabsf(den), expf(-m_t));
        const float ss = wave_sum(hv * hv); if (lane == 0) sred[8 + wid] = ss; }
    __syncthreads();
    if (tid < 256) { const float ss = (sred[8] + sred[9]) + (sred[10] + sred[11]); const float rinv = rsqrtf(ss * (1.f / 256.f) + RMS_EPS);
        const int col = h * 256 + tid; const size_t ro = row * 1024 + col;
        const float ym = sigmoidf_(bflo((unsigned)MO[ro])) * hv * rinv * inptr(IN_MNG)[col];
        const float o = sigmoidf_(bflo((unsigned)GM[ro])) * ym + sigmoidf_(bflo((unsigned)GA[ro])) * bflo((unsigned)YA[ro]);
        GM[ro] = bf1(o); }
    __syncthreads();
}

DI void ln1_rows(Frame& F) {
    const int gw = F.bid * 8 + F.wave, NGW = F.G * 8, lane = launder_v(F.lane);
    const float* U1 = (const float*)(F.ws + WS_U1); bf16_t* X1 = (bf16_t*)(F.ws + WS_X1); bf16_t* PB = (bf16_t*)(F.ws + WS_PB);
    f32x4 g4[4], b4[4];
#pragma unroll
    for (int j = 0; j < 4; ++j) { g4[j] = *(const f32x4*)(inptr(IN_LN1G) + 4 * lane + 256 * j); b4[j] = *(const f32x4*)(inptr(IN_LN1B) + 4 * lane + 256 * j); }
    for (int m = gw; m < MP; m += NGW) {
        unsigned long long* o8 = (unsigned long long*)(X1 + (size_t)m * 1024) + lane; unsigned long long* p8 = (unsigned long long*)(PB + (size_t)m * 256) + lane;
        if (m >= NTOK) {
#pragma unroll
            for (int j = 0; j < 4; ++j) o8[64 * j] = 0ull;
            *p8 = 0ull; continue; }
        const float* src = U1 + (size_t)m * 1024;
        f32x4 v[4]; float s = 0.f;
#pragma unroll
        for (int j = 0; j < 4; ++j) { v[j] = *(const f32x4*)(src + 4 * lane + 256 * j); s += (v[j].x + v[j].y) + (v[j].z + v[j].w); }
        const float mean = wave_sum(s) * (1.f / 1024.f); float s2 = 0.f;
#pragma unroll
        for (int j = 0; j < 4; ++j) { v[j] = v[j] - mean; s2 += (v[j].x * v[j].x + v[j].y * v[j].y) + (v[j].z * v[j].z + v[j].w * v[j].w); }
        const float rstd = 1.f / sqrtf(wave_sum(s2) * (1.f / 1024.f) + LN_EPS);
#pragma unroll
        for (int j = 0; j < 4; ++j) { v[j] = v[j] * rstd * g4[j] + b4[j];
            o8[64 * j] = (unsigned long long)cvt_pk_bf16(v[j].x, v[j].y) | ((unsigned long long)cvt_pk_bf16(v[j].z, v[j].w) << 32); }
        const float* ps = m < NP ? inptr(IN_PP) + (size_t)m * 256 : inptr(IN_PS) + (size_t)(m - NP) * 256;
        const f32x4 pv = *(const f32x4*)(ps + 4 * lane);
        *p8 = (unsigned long long)cvt_pk_bf16(pv.x, pv.y) | ((unsigned long long)cvt_pk_bf16(pv.z, pv.w) << 32);
    }
}
DI void ln2_rows(Frame& F) {
    const int gw = F.bid * 8 + F.wave, NGW = F.G * 8, lane = launder_v(F.lane);
    f32x4 g4[4], b4[4];
#pragma unroll
    for (int j = 0; j < 4; ++j) { g4[j] = *(const f32x4*)(inptr(IN_LN2G) + 4 * lane + 256 * j); b4[j] = *(const f32x4*)(inptr(IN_LN2B) + 4 * lane + 256 * j); }
    for (int m = gw; m < NTOK; m += NGW) {
        float* src = F.out + O_Y + (size_t)m * 1024;
        f32x4 v[4]; float s = 0.f;
#pragma unroll
        for (int j = 0; j < 4; ++j) { v[j] = *(const f32x4*)(src + 4 * lane + 256 * j); s += (v[j].x + v[j].y) + (v[j].z + v[j].w); }
        const float mean = wave_sum(s) * (1.f / 1024.f); float s2 = 0.f;
#pragma unroll
        for (int j = 0; j < 4; ++j) { v[j] = v[j] - mean; s2 += (v[j].x * v[j].x + v[j].y * v[j].y) + (v[j].z * v[j].z + v[j].w * v[j].w); }
        const float rstd = 1.f / sqrtf(wave_sum(s2) * (1.f / 1024.f) + LN_EPS);
#pragma unroll
        for (int j = 0; j < 4; ++j) *(f32x4*)(src + 4 * lane + 256 * j) = v[j] * rstd * g4[j] + b4[j];
    }
}
DI void p2_copies(Frame& F) {
    const int gt = F.bid * 512 + F.tid, NT = F.G * 512;
    const bf16_t* QK = (const bf16_t*)(F.ws + WS_QK); const bf16_t* AKV = (const bf16_t*)(F.ws + WS_AKV);
    for (int idx = gt; idx < 8 * 3 * 1024; idx += NT) { const int b = idx / 3072, rem = idx % 3072, i = rem >> 10, c = rem & 1023;
        F.out[O_CONVP + idx] = bflo((unsigned)QK[((size_t)b * SEQ + SEQ - 3 + i) * 1024 + c]); }
    for (int idx = gt; idx < 8 * 128 * 128; idx += NT) { const int b = idx >> 14, kk = (idx >> 7) & 127, c = idx & 127; const size_t rw = ((size_t)b * SEQ + SEQ - 128 + kk) * 256;
        F.out[O_KP + idx] = bflo((unsigned)AKV[rw + c]); F.out[O_VP + idx] = bflo((unsigned)AKV[rw + 128 + c]); }
}

__global__ void __launch_bounds__(512, 2) fwd_megakernel(Args args) {
    extern __shared__ __attribute__((aligned(16))) unsigned char lds_raw[];
    cg::grid_group grid = cg::this_grid();
    Frame F;
    F.lds = (LAS unsigned char*)lds_raw; F.tid = threadIdx.x; F.lane = F.tid & 63; F.wave = __builtin_amdgcn_readfirstlane(F.tid >> 6); F.G = gridDim.x; F.bid = blockIdx.x;
    F.out = args.out; F.ws = args.ws;
    unsigned char* ws = F.ws;
    if (F.tid < 2) ((volatile LAS unsigned*)(F.lds + LDS_MISC))[F.tid] = 0u;
    __syncthreads();
    XcdBarrier bar = xcd_barrier_post((unsigned*)ws + CW_BAR, (volatile LAS unsigned*)(F.lds + LDS_MISC));
    for (int rep = 0; rep < REP_MISC; ++rep) p0_prologue(F);
    grid.sync();
    for (int rep = 0; rep < REP_G; ++rep)
    { pg8::Gemm g{(const bf16_t*)(ws + WS_XN), (const bf16_t*)(ws + WS_WIN), MP, NZ, 1024}; pg8::StaticOrder S; S.init(MP, NZ, F.G, F.bid);
      epi::EpiZ E{ws}; pg8::gemm_phase<epi::EpiZ, pg8::StaticOrder, true, true>(F.lds, g, S, E); }
    xcd_barrier(bar);
    for (int rep = 0; rep < REP_P2; ++rep) {
        for (int it = F.bid; it < 512; it += F.G) mlstm_a_item(F, it);
        bf16_t* od = rep == REP_P2 - 1 ? (bf16_t*)(ws + WS_AQ) : (bf16_t*)(F.out + O_CS);
        for (int it = F.bid; it < 1024; it += F.G) attn_unit(F, it, od);
    }
    for (int it = F.bid; it < 128; it += F.G) sattn_item(F, it);
    p2_copies(F);
    xcd_barrier(bar);
    for (int rep = 0; rep < REP_MISC; ++rep)
    for (int it = F.bid; it < 256; it += F.G) scan_item(F, it);
    xcd_barrier(bar);
    for (int rep = 0; rep < REP_P4; ++rep) {
        bf16_t* od = rep == REP_P4 - 1 ? (bf16_t*)(ws + WS_GM) : (bf16_t*)(F.out + O_DC);
        for (int it = F.bid; it < 512; it += F.G) mlstm_c_item(F, it, od);
    }
    for (int it = F.bid; it < 512; it += F.G) smlstm_item(F, it);
    xcd_barrier(bar);
    for (int rep = 0; rep < REP_G; ++rep)
    { pg8::Gemm g{(const bf16_t*)(ws + WS_GM), (const bf16_t*)(ws + WS_WOUT), MP, 1024, 1024}; pg8::StaticOrder S; S.init(MP, 1024, F.G, F.bid);
      epi::EpiU1 E{(const bf16_t*)(ws + WS_XN), (float*)(ws + WS_U1)}; pg8::gemm_phase<epi::EpiU1, pg8::StaticOrder, true, true>(F.lds, g, S, E); }
    xcd_barrier(bar);
    for (int rep = 0; rep < REP_MISC; ++rep) ln1_rows(F);
    xcd_barrier(bar);
    for (int rep = 0; rep < REP_G; ++rep) {
    { pg8::Gemm g{(const bf16_t*)(ws + WS_X1), (const bf16_t*)(ws + WS_WGU), MP, 2 * DFF, 1024}; pg8::StaticOrder S; S.init(MP, 2 * DFF, F.G, F.bid);
      epi::EpiGU E{(bf16_t*)(ws + WS_ACT)}; pg8::gemm_phase<epi::EpiGU, pg8::StaticOrder, true, true>(F.lds, g, S, E); }
    { int kpd = PD; asm volatile("" : "+s"(kpd)); pg8::Gemm g{(const bf16_t*)(ws + WS_PB), (const bf16_t*)(ws + WS_WPLE), MP, 1024, kpd}; pg8::StaticOrder S; S.init(MP, 1024, F.G, F.bid);
      epi::EpiT1 E{(bf16_t*)(ws + WS_T1)}; pg8::gemm_phase<epi::EpiT1, pg8::StaticOrder, true, true>(F.lds, g, S, E); }
    { pg8::Gemm g{(const bf16_t*)(ws + WS_X1), (const bf16_t*)(ws + WS_WPG), MP, 1024, 1024}; pg8::StaticOrder S; S.init(MP, 1024, F.G, F.bid);
      epi::EpiPLE E{(const bf16_t*)(ws + WS_T1), (bf16_t*)(ws + WS_PLE)}; pg8::gemm_phase<epi::EpiPLE, pg8::StaticOrder, true, true>(F.lds, g, S, E); }
    }
    xcd_barrier(bar);
    for (int rep = 0; rep < REP_G; ++rep)
    { pg8::Gemm g{(const bf16_t*)(ws + WS_ACT), (const bf16_t*)(ws + WS_WDN), MP, 1024, DFF}; pg8::StaticOrder S; S.init(MP, 1024, F.G, F.bid);
      epi::EpiDN E{(const bf16_t*)(ws + WS_X1), (const bf16_t*)(ws + WS_PLE), F.out + O_Y}; pg8::gemm_phase<epi::EpiDN, pg8::StaticOrder, true, true>(F.lds, g, S, E); }
    xcd_barrier(bar);
    ln2_rows(F);
}

extern "C" void kernel_launch(void* const* d_in, const int* in_sizes, int n_in, void* d_out, int out_size, void* d_ws, size_t ws_size, hipStream_t stream) {
    static int grid = 0;
    if (grid == 0) {
        if (n_in != 28 || (size_t)out_size != O_END || ws_size < WS_END) { fprintf(stderr, "kernel_launch: shape mismatch n_in %d out %d (want %zu) ws %zu (want %zu)\n", n_in, out_size, (size_t)O_END, ws_size, (size_t)WS_END); grid = -1; return; }
        int dev = 0, cus = 0, per_cu = 0;
        hipGetDevice(&dev); hipDeviceGetAttribute(&cus, hipDeviceAttributeMultiprocessorCount, dev);
        hipFuncSetAttribute((const void*)fwd_megakernel, hipFuncAttributeMaxDynamicSharedMemorySize, LDS_BYTES);
        hipOccupancyMaxActiveBlocksPerMultiprocessor(&per_cu, (const void*)fwd_megakernel, 512, LDS_BYTES);
        if (per_cu < 1) per_cu = 1;
        grid = cus * per_cu;
        (void)hipGetLastError();
    }
    if (grid < 0) return;
    if (hipMemsetAsync(d_ws, 0, 65536, stream) != hipSuccess) { fprintf(stderr, "kernel_launch: memset of barrier words failed\n"); return; }
    Args a{};
    for (int i = 0; i < 28; ++i) a.in[i] = (const float*)d_in[i];
    a.out = (float*)d_out; a.ws = (unsigned char*)d_ws;
    void* kargs[] = {&a};
    hipError_t e = hipLaunchCooperativeKernel((const void*)fwd_megakernel, dim3(grid), dim3(512), kargs, LDS_BYTES, stream);
    if (e != hipSuccess) fprintf(stderr, "cooperative launch failed: %s (grid %d)\n", hipGetErrorString(e), grid);
}
```
